# Optimizing an MI355X kernel written in HIP

```python
import math
import jax, jax.numpy as jnp
from jax import lax
import numpy as np

D_MODEL = 2048
BATCH = 16
SEQ = 2048
DEPTH = 1

N_Q_HEADS = 16
N_KV_HEADS = 4
Q_GROUP = N_Q_HEADS // N_KV_HEADS
HEAD_DIM = 128
WINDOW = 128
BLOCK = 128
ATTN_WIDTH = N_Q_HEADS * HEAD_DIM
KV_WIDTH = N_KV_HEADS * HEAD_DIM

SSM_WIDTH = D_MODEL // 2
SSM_GROUP = 16
SSM_GROUPS = SSM_WIDTH // SSM_GROUP
SSM_STATE = 64
DT_MIN = 1e-3
DT_MAX = 1e-1

PEER_HEADS = 8
N_KEYS = 128
N_EXPERTS = N_KEYS * N_KEYS
PEER_QDIM = 256
PEER_HALF = PEER_QDIM // 2
PEER_TOPK = 16
PEER_TOKEN_BLOCK = 128

RMS_EPS = 1e-6
IN_WIDTH = ATTN_WIDTH + 2 * KV_WIDTH + SSM_WIDTH + 2 * D_MODEL
IN_SPLITS = (ATTN_WIDTH, ATTN_WIDTH + KV_WIDTH, ATTN_WIDTH + 2 * KV_WIDTH,
             ATTN_WIDTH + 2 * KV_WIDTH + SSM_WIDTH,
             ATTN_WIDTH + 2 * KV_WIDTH + SSM_WIDTH + D_MODEL)

kernel_name = "hybrid_swa_s5_peer_encoder"


def rms_norm(x, g):
    xf = x.astype(jnp.float32)
    y = xf * lax.rsqrt(jnp.mean(xf * xf, axis=-1, keepdims=True) + RMS_EPS)
    return (y * g.astype(jnp.float32)).astype(x.dtype)


def alibi_slopes(n_heads):
    return jnp.exp2(-8.0 * (jnp.arange(n_heads, dtype=jnp.float32) + 1.0) / n_heads)


def windowed_gqa(q, k, v, sink):
    b_, s_ = q.shape[0], q.shape[1]
    nb = s_ // BLOCK
    qb = q.reshape(b_, nb, BLOCK, N_KV_HEADS, Q_GROUP, HEAD_DIM).transpose(1, 0, 2, 3, 4, 5)
    pad = ((0, 0), (BLOCK, BLOCK), (0, 0), (0, 0))

    def band(t):
        tp = jnp.pad(t, pad).reshape(b_, nb + 2, BLOCK, N_KV_HEADS, HEAD_DIM)
        tw = jnp.concatenate([tp[:, :-2], tp[:, 1:-1], tp[:, 2:]], axis=2)
        return tw.transpose(1, 0, 2, 3, 4)

    kw, vw = band(k), band(v)
    slopes = alibi_slopes(N_Q_HEADS).reshape(N_KV_HEADS, Q_GROUP)[:, :, None, None]
    sink_f = sink.astype(jnp.float32).reshape(N_KV_HEADS, Q_GROUP)[:, :, None, None]
    scale = HEAD_DIM ** -0.5

    def block_attn(args):
        blk, qi, ki, vi = args
        qpos = blk * BLOCK + jnp.arange(BLOCK)
        kpos = (blk - 1) * BLOCK + jnp.arange(3 * BLOCK)
        dist = jnp.abs(qpos[:, None] - kpos[None, :])
        valid = (dist <= WINDOW) & (kpos >= 0) & (kpos < s_)
        s = jnp.einsum('bqkgd,bskd->bkgqs', qi.astype(jnp.float32), ki.astype(jnp.float32)) * scale
        s = s - slopes * dist.astype(jnp.float32)
        s = jnp.where(valid, s, -jnp.inf)
        m = jnp.maximum(jnp.max(s, axis=-1, keepdims=True), sink_f)
        p = jnp.exp(s - m)
        denom = jnp.sum(p, axis=-1, keepdims=True) + jnp.exp(sink_f - m)
        o = jnp.einsum('bkgqs,bskd->bqkgd', p / denom, vi.astype(jnp.float32))
        return o.astype(q.dtype)

    out = lax.map(block_attn, (jnp.arange(nb), qb, kw, vw))
    return out.transpose(1, 0, 2, 3, 4, 5).reshape(b_, s_, ATTN_WIDTH)


def _ssm_combine(left, right):
    a_l, b_l = left
    a_r, b_r = right
    return a_r * a_l, a_r * b_l + b_r


def s5_direction(u, a_re, a_im, log_step, b_re, b_im, c_re, c_im, reverse):
    s_ = u.shape[1]
    lam = lax.complex(a_re.astype(jnp.float32), a_im.astype(jnp.float32))
    step = jnp.exp(log_step.astype(jnp.float32))[:, None]
    lam_bar = jnp.exp(lam * step)
    b_mat = lax.complex(b_re.astype(jnp.float32), b_im.astype(jnp.float32))
    b_bar = ((lam_bar - 1.0) / lam)[:, :, None] * b_mat
    bu = jnp.einsum('bsgc,gnc->bsgn', u.astype(jnp.complex64), b_bar)
    a = jnp.broadcast_to(lam_bar[None, None], (1, s_, SSM_GROUPS, SSM_STATE))
    _, states = lax.associative_scan(_ssm_combine, (a, bu), reverse=reverse, axis=1)
    c_mat = lax.complex(c_re.astype(jnp.float32), c_im.astype(jnp.float32))
    return jnp.real(jnp.einsum('bsgn,gcn->bsgc', states, c_mat))


def peer(h, w_query, sub_keys_1, sub_keys_2, expert_down, expert_up):
    b_, s_, d_ = h.shape
    t_ = b_ * s_
    ht = h.reshape(t_, d_)
    q = (ht @ w_query).astype(jnp.float32).reshape(t_, PEER_HEADS, 2, PEER_HALF)
    s1 = jnp.einsum('thd,hkd->thk', q[:, :, 0], sub_keys_1.astype(jnp.float32))
    s2 = jnp.einsum('thd,hkd->thk', q[:, :, 1], sub_keys_2.astype(jnp.float32))
    v1, i1 = lax.top_k(s1, PEER_TOPK)
    v2, i2 = lax.top_k(s2, PEER_TOPK)
    cand = (v1[..., :, None] + v2[..., None, :]).reshape(t_, PEER_HEADS, PEER_TOPK * PEER_TOPK)
    cand_idx = (i1[..., :, None] * N_KEYS + i2[..., None, :]).reshape(t_, PEER_HEADS, PEER_TOPK * PEER_TOPK)
    top_s, pos = lax.top_k(cand, PEER_TOPK)
    idx = jnp.take_along_axis(cand_idx, pos, axis=-1)
    gate = jax.nn.softmax(top_s, axis=-1)
    nblk = t_ // PEER_TOKEN_BLOCK
    k_sel = PEER_HEADS * PEER_TOPK
    xs = (ht.reshape(nblk, PEER_TOKEN_BLOCK, d_),
          idx.reshape(nblk, PEER_TOKEN_BLOCK, k_sel),
          gate.reshape(nblk, PEER_TOKEN_BLOCK, k_sel))

    def token_block(args):
        hb, ib, gb = args
        u_sel = jnp.take(expert_down, ib, axis=0)
        act = jnp.einsum('tkd,td->tk', u_sel.astype(jnp.float32), hb.astype(jnp.float32))
        w = gb * jax.nn.gelu(act, approximate=False)
        v_sel = jnp.take(expert_up, ib, axis=0)
        return jnp.einsum('tk,tkd->td', w, v_sel.astype(jnp.float32))

    return lax.map(token_block, xs).reshape(b_, s_, d_)


def setup_inputs(seed: int = 0) -> dict:
    key = jax.random.key(seed)
    ks = jax.random.split(key, 24)
    L, D, f32 = DEPTH, D_MODEL, jnp.float32
    G, N, C = SSM_GROUPS, SSM_STATE, SSM_GROUP
    nrm = lambda k, shape, sc: jax.random.normal(k, shape, f32) * sc
    a_im_base = jnp.pi * jnp.arange(N, dtype=f32)
    return {
        "x": nrm(ks[0], (BATCH, SEQ, D), 1.0),
        "mix_norm_g": 1.0 + nrm(ks[1], (L, D), 0.02),
        "w_in": nrm(ks[2], (L, D, IN_WIDTH), D ** -0.5),
        "q_norm_g": 1.0 + nrm(ks[3], (L, HEAD_DIM), 0.02),
        "k_norm_g": 1.0 + nrm(ks[4], (L, HEAD_DIM), 0.02),
        "attn_sink": nrm(ks[5], (L, N_Q_HEADS), 0.5),
        "w_attn_o": nrm(ks[6], (L, ATTN_WIDTH, D), ATTN_WIDTH ** -0.5),
        "ssm_a_re": -0.5 + nrm(ks[7], (L, 2, G, N), 0.01),
        "ssm_a_im": a_im_base + nrm(ks[8], (L, 2, G, N), 0.01),
        "ssm_log_step": jax.random.uniform(ks[9], (L, 2, G), f32, math.log(DT_MIN), math.log(DT_MAX)),
        "ssm_b_re": nrm(ks[10], (L, 2, G, N, C), (2.0 * C) ** -0.5),
        "ssm_b_im": nrm(ks[11], (L, 2, G, N, C), (2.0 * C) ** -0.5),
        "ssm_c_re": nrm(ks[12], (L, 2, G, C, N), (2.0 * N) ** -0.5),
        "ssm_c_im": nrm(ks[13], (L, 2, G, C, N), (2.0 * N) ** -0.5),
        "ssm_d": nrm(ks[14], (L, SSM_WIDTH), 1.0),
        "glu_w_a": nrm(ks[15], (L, SSM_WIDTH, D), SSM_WIDTH ** -0.5),
        "glu_w_b": nrm(ks[16], (L, SSM_WIDTH, D), SSM_WIDTH ** -0.5),
        "w_out": nrm(ks[17], (L, D, D), D ** -0.5),
        "ffn_norm_g": 1.0 + nrm(ks[18], (L, D), 0.02),
        "peer_w_query": nrm(ks[19], (L, D, PEER_HEADS * PEER_QDIM), D ** -0.5),
        "peer_sub_keys_1": nrm(ks[20], (L, PEER_HEADS, N_KEYS, PEER_HALF), PEER_HALF ** -0.5),
        "peer_sub_keys_2": nrm(ks[21], (L, PEER_HEADS, N_KEYS, PEER_HALF), PEER_HALF ** -0.5),
        "peer_down": nrm(ks[22], (L, N_EXPERTS, D), D ** -0.5),
        "peer_up": nrm(ks[23], (L, N_EXPERTS, D), 0.25),
    }


def reference(x, mix_norm_g, w_in, q_norm_g, k_norm_g, attn_sink, w_attn_o,
              ssm_a_re, ssm_a_im, ssm_log_step, ssm_b_re, ssm_b_im, ssm_c_re, ssm_c_im, ssm_d,
              glu_w_a, glu_w_b, w_out, ffn_norm_g, peer_w_query, peer_sub_keys_1,
              peer_sub_keys_2, peer_down, peer_up):
    b_, s_ = x.shape[0], x.shape[1]
    for l in range(DEPTH):
        h = rms_norm(x, mix_norm_g[l])
        proj = h @ w_in[l]
        q, k, v, u, gate_a, gate_b = jnp.split(proj, IN_SPLITS, axis=-1)
        q = rms_norm(q.reshape(b_, s_, N_Q_HEADS, HEAD_DIM), q_norm_g[l])
        k = rms_norm(k.reshape(b_, s_, N_KV_HEADS, HEAD_DIM), k_norm_g[l])
        v = v.reshape(b_, s_, N_KV_HEADS, HEAD_DIM)
        y_a = windowed_gqa(q, k, v, attn_sink[l]) @ w_attn_o[l]

        ug = u.astype(jnp.float32).reshape(b_, s_, SSM_GROUPS, SSM_GROUP)
        y_fwd = s5_direction(ug, ssm_a_re[l, 0], ssm_a_im[l, 0], ssm_log_step[l, 0],
                             ssm_b_re[l, 0], ssm_b_im[l, 0], ssm_c_re[l, 0], ssm_c_im[l, 0], False)
        y_bwd = s5_direction(ug, ssm_a_re[l, 1], ssm_a_im[l, 1], ssm_log_step[l, 1],
                             ssm_b_re[l, 1], ssm_b_im[l, 1], ssm_c_re[l, 1], ssm_c_im[l, 1], True)
        y_ssm = (y_fwd + y_bwd).reshape(b_, s_, SSM_WIDTH) + ssm_d[l] * ug.reshape(b_, s_, SSM_WIDTH)
        y_act = jax.nn.gelu(y_ssm, approximate=False)
        y_b = (y_act @ glu_w_a[l]) * jax.nn.sigmoid(y_act @ glu_w_b[l])

        merged = jax.nn.sigmoid(gate_a) * y_a + jax.nn.sigmoid(gate_b) * y_b
        x = x + merged @ w_out[l]

        h2 = rms_norm(x, ffn_norm_g[l])
        x = x + peer(h2, peer_w_query[l], peer_sub_keys_1[l], peer_sub_keys_2[l],
                     peer_down[l], peer_up[l])
    return x
```

```cpp
#include <hip/hip_runtime.h>
#include <cstdio>
#include <cstdint>
#include <cmath>

constexpr int D_MODEL = 2048, BATCH = 16, SEQ = 2048, T_TOK = BATCH * SEQ;
constexpr int NQH = 16, NKVH = 4, HD = 128, WINDOW = 128;
constexpr int SSM_W = 1024, SSM_G = 64, SSM_N = 64, SSM_C = 16;
constexpr int PEER_H = 8, NKEYS = 128, NEXP = NKEYS * NKEYS, PEER_HALF = 128, PEER_TOPK = 16, KSEL = PEER_H * PEER_TOPK;
constexpr int IN_W = 8192;
constexpr float RMS_EPS = 1e-6f;

#define GAS __attribute__((address_space(1)))
#define LAS __attribute__((address_space(3)))
typedef unsigned short bf16;
typedef unsigned v4u __attribute__((ext_vector_type(4)));
typedef unsigned v2u __attribute__((ext_vector_type(2)));
typedef float f32x4 __attribute__((ext_vector_type(4)));
typedef float f32x2_t __attribute__((ext_vector_type(2)));
typedef __bf16 bf16x2_t __attribute__((ext_vector_type(2)));
#define LDS_WAIT() asm volatile("s_waitcnt lgkmcnt(0)" ::: "memory")
#define VM_WAIT() asm volatile("s_waitcnt vmcnt(0)" ::: "memory")
#define RLX_AGENT __ATOMIC_RELAXED, __HIP_MEMORY_SCOPE_AGENT
typedef GAS unsigned gu32;

__device__ __forceinline__ unsigned pk2(float lo, float hi) { f32x2_t v = {lo, hi}; bf16x2_t b = __builtin_convertvector(v, bf16x2_t); return __builtin_bit_cast(unsigned, b); }
__device__ __forceinline__ float bflo(unsigned w) { return __uint_as_float(w << 16); }
__device__ __forceinline__ float bfhi(unsigned w) { return __uint_as_float(w & 0xffff0000u); }
__device__ __forceinline__ float wave_sum(float v) {
#pragma unroll
    for (int o = 1; o < 64; o <<= 1) v += __shfl_xor(v, o);
    return v;
}
__device__ __forceinline__ float wave_max(float v) {
#pragma unroll
    for (int o = 1; o < 64; o <<= 1) v = fmaxf(v, __shfl_xor(v, o));
    return v;
}
__device__ __forceinline__ float sigmoidf_(float x) { return __builtin_amdgcn_rcpf(1.f + __expf(-x)); }
__device__ __forceinline__ float gelu_erf(float x) { return 0.5f * x * (1.f + erff(x * 0.70710678118654752f)); }

namespace pg8 {
#define PG8_LAS __attribute__((address_space(3)))
typedef unsigned short bf16_t;
typedef short bf16x8 __attribute__((ext_vector_type(8)));
typedef float f32x4 __attribute__((ext_vector_type(4)));
typedef unsigned u32x4 __attribute__((ext_vector_type(4)));
typedef int v4i_t __attribute__((ext_vector_type(4)));
typedef int v8i_t __attribute__((ext_vector_type(8)));
constexpr int BM = 256, BK = 64, HALF = 128, HTB = HALF * BK * 2  , STAGE_BYTES = 8 * HTB, NXCD = 8, WGM = 8;

__host__ __device__ __forceinline__ int lds_byte(int r, int c) { const int st = (r >> 4) * 2 + (c >> 5), rr = r & 15, cc = c & 31, ob = rr * 64 + cc * 2; return st * 1024 + (ob ^ (((ob >> 9) & 1) << 5)); }
__host__ __device__ __forceinline__ void stage_rc(int b, int& R, int& C) { const int st = b / 1024, sb = b % 1024, swz = sb ^ (((sb >> 9) & 1) << 5); R = (st >> 1) * 16 + swz / 64; C = (st & 1) * 32 + (swz % 64) / 2; }
__host__ __device__ __forceinline__ int perm32(int rho) { const int n = rho >> 4, i = rho & 15; return 8 * (i >> 2) + 4 * n + (i & 3); }

struct Unit { int pm, pn; };
struct Gemm { const bf16_t* A; const bf16_t* Bt; int M, N, K; int amode; };

struct StaticOrder {
    int nM, nN, nwg, G, c;
    __host__ __device__ void init(int M, int N, int G_, int c_) { nM = M / BM; nN = N / BM; nwg = nM * nN; G = G_; c = c_; }
    __host__ __device__ bool next(int i, Unit& u) const {
        const long L = (long)i * G + c; if (L >= nwg) return false;
        int wgid = (int)L; { const int q = nwg / NXCD, r = nwg % NXCD, xcd = wgid % NXCD, off = wgid / NXCD; wgid = (xcd < r ? xcd * (q + 1) : r * (q + 1) + (xcd - r) * q) + off; }
        const int nig = WGM * nN, gid = wgid / nig, fm = gid * WGM, gsz = (nM - fm) < WGM ? (nM - fm) : WGM;
        u.pm = fm + ((wgid % nig) % gsz); u.pn = (wgid % nig) / gsz; return true;
    }
    __device__ __forceinline__ void a_ready(const Unit&) const {}
    __device__ __forceinline__ void done(const Unit&) const {}
};

__device__ __forceinline__ unsigned cvt_pk_bf16(float lo, float hi) { return ::pk2(lo, hi); }
__device__ __forceinline__ float sgm(float x) { return __builtin_amdgcn_rcpf(1.f + __expf(-x)); }

struct EpiProj {
    static constexpr bool PERM = true, AFTER_DRAIN = false;
    bf16_t* Q; bf16_t* KV; bf16_t* U; bf16_t* GT;
    __device__ __forceinline__ void operator()(const f32x4 (&acc)[2][2][4][2], const Unit& u, int wr, int wc, int fr, int fq) const {
        const int pn = u.pn; bf16_t* base; int ld, colt; bool sig = false;
        if (pn < 8) { base = Q; ld = 2048; colt = pn * 256; }
        else if (pn < 12) { base = KV; ld = 1024; colt = (pn - 8) * 256; }
        else if (pn < 16) { base = U; ld = 0; colt = (pn - 12) * 256; }
        else { base = GT; ld = 4096; colt = (pn - 16) * 256; sig = true; }
        const int row0 = u.pm * BM + wr * 64 + fr, col0 = colt + wc * 32 + 8 * fq;
#pragma unroll
        for (int ai = 0; ai < 2; ++ai)
#pragma unroll
            for (int m = 0; m < 4; ++m) { const int row = row0 + ai * HALF + m * 16; bf16_t* rowp = base + (size_t)row * ld + col0;
#pragma unroll
                for (int bj = 0; bj < 2; ++bj) { f32x4 v0 = acc[ai][bj][m][0], v1 = acc[ai][bj][m][1];
                    if (sig) {
#pragma unroll
                        for (int e = 0; e < 4; ++e) { v0[e] = sgm(v0[e]); v1[e] = sgm(v1[e]); } }
                    u32x4 w; w.x = cvt_pk_bf16(v0[0], v0[1]); w.y = cvt_pk_bf16(v0[2], v0[3]); w.z = cvt_pk_bf16(v1[0], v1[1]); w.w = cvt_pk_bf16(v1[2], v1[3]);
                    if (ld == 0) { const int col = col0 + bj * HALF; *(u32x4*)(base + (((size_t)(row >> 11) * 64 + (col >> 4)) * 2048 + (row & 2047)) * 16 + (col & 8)) = w; }
                    else *(u32x4*)(rowp + bj * HALF) = w; } }
    }
};
struct EpiProj8 {
    static constexpr bool PERM = true, AFTER_DRAIN = false;
    unsigned char* ws; size_t o_q, o_kv, o_u, o_gt, o_hs, o_amax;
    __device__ __forceinline__ void operator()(const f32x4 (&acc)[2][2][4][2], const Unit& u, int wr, int wc, int fr, int fq) const {
        asm volatile("s_nop 15\n\ts_nop 15" ::: "memory");
        const float* HS = (const float*)(ws + o_hs); const float* AMAX = (const float*)(ws + o_amax);
        const int pn = u.pn; bf16_t* base; int ld, colt; bool sig = false;
        if (pn < 8) { base = (bf16_t*)(ws + o_q); ld = 2048; colt = pn * 256; }
        else if (pn < 12) { base = (bf16_t*)(ws + o_kv); ld = 1024; colt = (pn - 8) * 256; }
        else if (pn < 16) { base = (bf16_t*)(ws + o_u); ld = 0; colt = (pn - 12) * 256; }
        else { base = (bf16_t*)(ws + o_gt); ld = 4096; colt = (pn - 16) * 256; sig = true; }
        const int row0 = u.pm * BM + wr * 64 + fr, col0 = colt + wc * 32 + 8 * fq, acol0 = pn * 256 + wc * 32 + 8 * fq;
        float hsv[2][4]; f32x4 cv[2][2];
#pragma unroll
        for (int ai = 0; ai < 2; ++ai)
#pragma unroll
            for (int m = 0; m < 4; ++m) hsv[ai][m] = HS[row0 + ai * HALF + m * 16];
#pragma unroll
        for (int bj = 0; bj < 2; ++bj) { cv[bj][0] = *(const f32x4*)(AMAX + acol0 + bj * HALF) * (1.0f / 440.0f); cv[bj][1] = *(const f32x4*)(AMAX + acol0 + bj * HALF + 4) * (1.0f / 440.0f); }
        __builtin_amdgcn_sched_barrier(0);
#pragma unroll
        for (int bj = 0; bj < 2; ++bj) {
            const f32x4 c0 = cv[bj][0], c1 = cv[bj][1];
#pragma unroll
            for (int ai = 0; ai < 2; ++ai)
#pragma unroll
                for (int m = 0; m < 4; ++m) { const int row = row0 + ai * HALF + m * 16; const float hs = hsv[ai][m];
                    f32x4 v0 = acc[ai][bj][m][0] * c0 * hs, v1 = acc[ai][bj][m][1] * c1 * hs;
                    if (sig) {
#pragma unroll
                        for (int e = 0; e < 4; ++e) { v0[e] = sgm(v0[e]); v1[e] = sgm(v1[e]); } }
                    u32x4 w; w.x = cvt_pk_bf16(v0[0], v0[1]); w.y = cvt_pk_bf16(v0[2], v0[3]); w.z = cvt_pk_bf16(v1[0], v1[1]); w.w = cvt_pk_bf16(v1[2], v1[3]);
                    const int col = col0 + bj * HALF;
                    if (ld == 0) *(u32x4*)(base + (((size_t)(row >> 11) * 64 + (col >> 4)) * 2048 + (row & 2047)) * 16 + (col & 8)) = w;
                    else *(u32x4*)(base + (size_t)row * ld + col) = w; }
        }
    }
};
struct EpiGateMul8 {
    static constexpr bool PERM = true, AFTER_DRAIN = false;
    unsigned char* ws; size_t o_out, o_gate, o_amax; float inv_scale;
    __device__ __forceinline__ void operator()(const f32x4 (&acc)[2][2][4][2], const Unit& u, int wr, int wc, int fr, int fq) const {
        asm volatile("s_nop 15\n\ts_nop 15" ::: "memory");
        bf16_t* O = (bf16_t*)(ws + o_out); const bf16_t* G = (const bf16_t*)(ws + o_gate); const float* AMAX = (const float*)(ws + o_amax);
        const int row0 = u.pm * BM + wr * 64 + fr, col0 = u.pn * BM + wc * 32 + 8 * fq;
        u32x4 gl[2][2][4];
#pragma unroll
        for (int bj = 0; bj < 2; ++bj)
#pragma unroll
            for (int ai = 0; ai < 2; ++ai)
#pragma unroll
                for (int m = 0; m < 4; ++m) gl[bj][ai][m] = *(const u32x4*)(G + (size_t)(row0 + ai * HALF + m * 16) * 4096 + col0 + bj * HALF);
        __builtin_amdgcn_sched_barrier(0);
#pragma unroll
        for (int bj = 0; bj < 2; ++bj) {
            const f32x4 c0 = *(const f32x4*)(AMAX + col0 + bj * HALF) * inv_scale, c1 = *(const f32x4*)(AMAX + col0 + bj * HALF + 4) * inv_scale;
#pragma unroll
            for (int ai = 0; ai < 2; ++ai)
#pragma unroll
                for (int m = 0; m < 4; ++m) { const size_t r = (size_t)(row0 + ai * HALF + m * 16);
                    const f32x4 v0 = acc[ai][bj][m][0] * c0, v1 = acc[ai][bj][m][1] * c1;
                    const u32x4 g = gl[bj][ai][m];
                    u32x4 w; w.x = cvt_pk_bf16(v0[0] * ::bflo(g.x), v0[1] * ::bfhi(g.x)); w.y = cvt_pk_bf16(v0[2] * ::bflo(g.y), v0[3] * ::bfhi(g.y));
                    w.z = cvt_pk_bf16(v1[0] * ::bflo(g.z), v1[1] * ::bfhi(g.z)); w.w = cvt_pk_bf16(v1[2] * ::bflo(g.w), v1[3] * ::bfhi(g.w));
                    *(u32x4*)(O + r * 2048 + col0 + bj * HALF) = w; }
        }
    }
};
struct EpiGlu8 {
    static constexpr bool PERM = true, AFTER_DRAIN = false;
    unsigned char* ws; size_t o_out, o_ya, o_gb, o_amax; float inv_scale, out_scale;
    __device__ __forceinline__ void operator()(const f32x4 (&acc)[2][2][4][2], const Unit& u, int wr, int wc, int fr, int fq) const {
        asm volatile("s_nop 15\n\ts_nop 15" ::: "memory");
        bf16_t* O = (bf16_t*)(ws + o_out); const bf16_t* YA = (const bf16_t*)(ws + o_ya); const bf16_t* GB = (const bf16_t*)(ws + o_gb); const float* AMAX = (const float*)(ws + o_amax);
        const int row0 = u.pm * BM + wr * 64 + fr, oc = u.pn * 128 + wc * 32 + 8 * fq, wrow = u.pn * BM + wc * 32 + 8 * fq;
        const f32x4 sa0 = *(const f32x4*)(AMAX + wrow) * inv_scale, sa1 = *(const f32x4*)(AMAX + wrow + 4) * inv_scale, sb0 = *(const f32x4*)(AMAX + wrow + HALF) * inv_scale, sb1 = *(const f32x4*)(AMAX + wrow + HALF + 4) * inv_scale;
        u32x4 yal[2][4], gbl[2][4];
#pragma unroll
        for (int ai = 0; ai < 2; ++ai)
#pragma unroll
            for (int m = 0; m < 4; ++m) { const size_t r = (size_t)(row0 + ai * HALF + m * 16); yal[ai][m] = *(const u32x4*)(YA + r * 2048 + oc); gbl[ai][m] = *(const u32x4*)(GB + r * 4096 + oc); }
        __builtin_amdgcn_sched_barrier(0);
#pragma unroll
        for (int ai = 0; ai < 2; ++ai)
#pragma unroll
            for (int m = 0; m < 4; ++m) { const size_t r = (size_t)(row0 + ai * HALF + m * 16);
                const u32x4 ya = yal[ai][m], gb = gbl[ai][m];
                const f32x4 a0 = acc[ai][0][m][0] * sa0, a1 = acc[ai][0][m][1] * sa1, b0 = acc[ai][1][m][0] * sb0, b1 = acc[ai][1][m][1] * sb1;
                float mv[8];
                mv[0] = ::bflo(ya.x) + ::bflo(gb.x) * (a0[0] * sgm(b0[0])); mv[1] = ::bfhi(ya.x) + ::bfhi(gb.x) * (a0[1] * sgm(b0[1]));
                mv[2] = ::bflo(ya.y) + ::bflo(gb.y) * (a0[2] * sgm(b0[2])); mv[3] = ::bfhi(ya.y) + ::bfhi(gb.y) * (a0[3] * sgm(b0[3]));
                mv[4] = ::bflo(ya.z) + ::bflo(gb.z) * (a1[0] * sgm(b1[0])); mv[5] = ::bfhi(ya.z) + ::bfhi(gb.z) * (a1[1] * sgm(b1[1]));
                mv[6] = ::bflo(ya.w) + ::bflo(gb.w) * (a1[2] * sgm(b1[2])); mv[7] = ::bfhi(ya.w) + ::bfhi(gb.w) * (a1[3] * sgm(b1[3]));
#pragma unroll
                for (int e = 0; e < 8; ++e) mv[e] = fminf(fmaxf(mv[e] * out_scale, -448.f), 448.f);
                int q0 = 0, q1 = 0; q0 = __builtin_amdgcn_cvt_pk_fp8_f32(mv[0], mv[1], q0, false); q0 = __builtin_amdgcn_cvt_pk_fp8_f32(mv[2], mv[3], q0, true);
                q1 = __builtin_amdgcn_cvt_pk_fp8_f32(mv[4], mv[5], q1, false); q1 = __builtin_amdgcn_cvt_pk_fp8_f32(mv[6], mv[7], q1, true);
                typedef unsigned u32x2 __attribute__((ext_vector_type(2)));
                *(u32x2*)((unsigned char*)O + r * 2048 + oc) = u32x2{(unsigned)q0, (unsigned)q1}; }
    }
};
struct EpiGateMul {
    static constexpr bool PERM = true, AFTER_DRAIN = false;
    bf16_t* O; int ldo; const bf16_t* G; int ldg;
    __device__ __forceinline__ void operator()(const f32x4 (&acc)[2][2][4][2], const Unit& u, int wr, int wc, int fr, int fq) const {
        const int row0 = u.pm * BM + wr * 64 + fr, col0 = u.pn * BM + wc * 32 + 8 * fq;
#pragma unroll
        for (int ai = 0; ai < 2; ++ai)
#pragma unroll
            for (int m = 0; m < 4; ++m) { const size_t r = (size_t)(row0 + ai * HALF + m * 16);
#pragma unroll
                for (int bj = 0; bj < 2; ++bj) { const f32x4 v0 = acc[ai][bj][m][0], v1 = acc[ai][bj][m][1];
                    const u32x4 g = *(const u32x4*)(G + r * ldg + col0 + bj * HALF);
                    u32x4 w; w.x = cvt_pk_bf16(v0[0] * ::bflo(g.x), v0[1] * ::bfhi(g.x)); w.y = cvt_pk_bf16(v0[2] * ::bflo(g.y), v0[3] * ::bfhi(g.y));
                    w.z = cvt_pk_bf16(v1[0] * ::bflo(g.z), v1[1] * ::bfhi(g.z)); w.w = cvt_pk_bf16(v1[2] * ::bflo(g.w), v1[3] * ::bfhi(g.w));
                    *(u32x4*)(O + r * ldo + col0 + bj * HALF) = w; } }
    }
};
struct EpiGlu {
    static constexpr bool PERM = true, AFTER_DRAIN = false;
    bf16_t* O; const bf16_t* YA; const bf16_t* GB; int ldg;
    __device__ __forceinline__ void operator()(const f32x4 (&acc)[2][2][4][2], const Unit& u, int wr, int wc, int fr, int fq) const {
        const int row0 = u.pm * BM + wr * 64 + fr, oc = u.pn * 128 + wc * 32 + 8 * fq;
#pragma unroll
        for (int ai = 0; ai < 2; ++ai)
#pragma unroll
            for (int m = 0; m < 4; ++m) { const size_t r = (size_t)(row0 + ai * HALF + m * 16);
                const u32x4 ya = *(const u32x4*)(YA + r * 2048 + oc), gb = *(const u32x4*)(GB + r * ldg + oc);
                const f32x4 a0 = acc[ai][0][m][0], a1 = acc[ai][0][m][1], b0 = acc[ai][1][m][0], b1 = acc[ai][1][m][1];
                u32x4 w;
                w.x = cvt_pk_bf16(::bflo(ya.x) + ::bflo(gb.x) * (a0[0] * sgm(b0[0])), ::bfhi(ya.x) + ::bfhi(gb.x) * (a0[1] * sgm(b0[1])));
                w.y = cvt_pk_bf16(::bflo(ya.y) + ::bflo(gb.y) * (a0[2] * sgm(b0[2])), ::bfhi(ya.y) + ::bfhi(gb.y) * (a0[3] * sgm(b0[3])));
                w.z = cvt_pk_bf16(::bflo(ya.z) + ::bflo(gb.z) * (a1[0] * sgm(b1[0])), ::bfhi(ya.z) + ::bfhi(gb.z) * (a1[1] * sgm(b1[1])));
                w.w = cvt_pk_bf16(::bflo(ya.w) + ::bflo(gb.w) * (a1[2] * sgm(b1[2])), ::bfhi(ya.w) + ::bfhi(gb.w) * (a1[3] * sgm(b1[3])));
                *(u32x4*)(O + r * 2048 + oc) = w; }
    }
};
struct EpiResid {
    static constexpr bool PERM = true, AFTER_DRAIN = false;
    const float* X; bf16_t* XB; float* SSQ;
    __device__ __forceinline__ void operator()(const f32x4 (&acc)[2][2][4][2], const Unit& u, int wr, int wc, int fr, int fq) const {
        const int row0 = u.pm * BM + wr * 64 + fr, col0 = u.pn * BM + wc * 32 + 8 * fq;
#pragma unroll
        for (int ai = 0; ai < 2; ++ai)
#pragma unroll
            for (int m = 0; m < 4; ++m) { const size_t r = (size_t)(row0 + ai * HALF + m * 16); float ss = 0.f;
#pragma unroll
                for (int bj = 0; bj < 2; ++bj) { const size_t off = r * 2048 + col0 + bj * HALF;
                    const f32x4 x0 = __builtin_nontemporal_load((const f32x4*)(X + off)) + acc[ai][bj][m][0], x1 = __builtin_nontemporal_load((const f32x4*)(X + off + 4)) + acc[ai][bj][m][1];
                    ss += ((x0[0] * x0[0] + x0[1] * x0[1]) + (x0[2] * x0[2] + x0[3] * x0[3])) + ((x1[0] * x1[0] + x1[1] * x1[1]) + (x1[2] * x1[2] + x1[3] * x1[3]));
                    u32x4 w; w.x = cvt_pk_bf16(x0[0], x0[1]); w.y = cvt_pk_bf16(x0[2], x0[3]); w.z = cvt_pk_bf16(x1[0], x1[1]); w.w = cvt_pk_bf16(x1[2], x1[3]); *(u32x4*)(XB + off) = w; }
                ss += __shfl_xor(ss, 16); ss += __shfl_xor(ss, 32);
                if (fq == 0) SSQ[r * 32 + u.pn * 4 + wc] = ss; }
    }
};
struct EpiResid8 {
    static constexpr bool PERM = true, AFTER_DRAIN = false;
    unsigned char* ws; const float* X; size_t o_xb, o_ssq, o_amax; float inv_scale;
    __device__ __forceinline__ void operator()(f32x4 (&acc)[2][2][4][2], const Unit& u, int wr, int wc, int fr, int fq) const {
        asm volatile("s_nop 15\n\ts_nop 15" ::: "memory");
        bf16_t* XB = (bf16_t*)(ws + o_xb); float* SSQ = (float*)(ws + o_ssq); const float* AMAX = (const float*)(ws + o_amax);
        const int row0 = u.pm * BM + wr * 64 + fr, col0 = u.pn * BM + wc * 32 + 8 * fq;
#pragma unroll
        for (int bj = 0; bj < 2; ++bj) { const f32x4 c0 = *(const f32x4*)(AMAX + col0 + bj * HALF) * inv_scale, c1 = *(const f32x4*)(AMAX + col0 + bj * HALF + 4) * inv_scale;
#pragma unroll
            for (int ai = 0; ai < 2; ++ai)
#pragma unroll
                for (int m = 0; m < 4; ++m) { acc[ai][bj][m][0] = acc[ai][bj][m][0] * c0; acc[ai][bj][m][1] = acc[ai][bj][m][1] * c1; } }
        __builtin_amdgcn_sched_barrier(0);
        f32x4 xv[2][2][2][2]; u32x4 w[2][2]; float ssv[2];
#define EPR_LOAD(q, B) _Pragma("unroll") for (int mm = 0; mm < 2; ++mm) _Pragma("unroll") for (int bj = 0; bj < 2; ++bj) { const size_t off = (size_t)(row0 + ((q) >> 1) * HALF + (2 * ((q) & 1) + mm) * 16) * 2048 + col0 + bj * HALF; \
            xv[B][mm][bj][0] = __builtin_nontemporal_load((const f32x4*)(X + off)); xv[B][mm][bj][1] = __builtin_nontemporal_load((const f32x4*)(X + off + 4)); }
#define EPR_COMP(q, B) _Pragma("unroll") for (int mm = 0; mm < 2; ++mm) { float ss = 0.f; _Pragma("unroll") for (int bj = 0; bj < 2; ++bj) { \
                const f32x4 x0 = xv[B][mm][bj][0] + acc[(q) >> 1][bj][2 * ((q) & 1) + mm][0], x1 = xv[B][mm][bj][1] + acc[(q) >> 1][bj][2 * ((q) & 1) + mm][1]; \
                ss += ((x0[0] * x0[0] + x0[1] * x0[1]) + (x0[2] * x0[2] + x0[3] * x0[3])) + ((x1[0] * x1[0] + x1[1] * x1[1]) + (x1[2] * x1[2] + x1[3] * x1[3])); \
                w[mm][bj].x = cvt_pk_bf16(x0[0], x0[1]); w[mm][bj].y = cvt_pk_bf16(x0[2], x0[3]); w[mm][bj].z = cvt_pk_bf16(x1[0], x1[1]); w[mm][bj].w = cvt_pk_bf16(x1[2], x1[3]); } \
            ss += __shfl_xor(ss, 16); ss += __shfl_xor(ss, 32); ssv[mm] = ss; }
#define EPR_STORE(q) _Pragma("unroll") for (int mm = 0; mm < 2; ++mm) { const size_t r = (size_t)(row0 + ((q) >> 1) * HALF + (2 * ((q) & 1) + mm) * 16); _Pragma("unroll") for (int bj = 0; bj < 2; ++bj) *(u32x4*)(XB + r * 2048 + col0 + bj * HALF) = w[mm][bj]; \
            if (fq == 0) SSQ[r * 32 + u.pn * 4 + wc] = ssv[mm]; }
#define EPR_SB __builtin_amdgcn_sched_barrier(0)
        EPR_LOAD(0, 0); EPR_LOAD(1, 1); EPR_SB;
        EPR_COMP(0, 0); EPR_SB; EPR_LOAD(2, 0); EPR_SB; EPR_STORE(0); EPR_SB;
        EPR_COMP(1, 1); EPR_SB; EPR_LOAD(3, 1); EPR_SB; EPR_STORE(1); EPR_SB;
        EPR_COMP(2, 0); EPR_SB; EPR_STORE(2); EPR_SB;
        EPR_COMP(3, 1); EPR_STORE(3);
#undef EPR_SB
#undef EPR_LOAD
#undef EPR_COMP
#undef EPR_STORE
    }
};
struct EpiPlain {
    static constexpr bool PERM = true, AFTER_DRAIN = false;
    bf16_t* O; int ldo;
    __device__ __forceinline__ void operator()(const f32x4 (&acc)[2][2][4][2], const Unit& u, int wr, int wc, int fr, int fq) const {
        const int row0 = u.pm * BM + wr * 64 + fr, col0 = u.pn * BM + wc * 32 + 8 * fq;
#pragma unroll
        for (int ai = 0; ai < 2; ++ai)
#pragma unroll
            for (int m = 0; m < 4; ++m) { bf16_t* rowp = O + (size_t)(row0 + ai * HALF + m * 16) * ldo + col0;
#pragma unroll
                for (int bj = 0; bj < 2; ++bj) { const f32x4 v0 = acc[ai][bj][m][0], v1 = acc[ai][bj][m][1];
                    u32x4 w; w.x = cvt_pk_bf16(v0[0], v0[1]); w.y = cvt_pk_bf16(v0[2], v0[3]); w.z = cvt_pk_bf16(v1[0], v1[1]); w.w = cvt_pk_bf16(v1[2], v1[3]);
                    *(u32x4*)(rowp + bj * HALF) = w; } }
    }
};

template <class Epi, class Sched, bool ALIGN_EPI = false, bool SP2 = false, bool FP8 = false>
__device__ __forceinline__ void gemm_phase(PG8_LAS unsigned char* lds, const Gemm g, const Sched& S, const Epi& E) {
    const int tid = threadIdx.x, wid = __builtin_amdgcn_readfirstlane(tid >> 6), lane = tid & 63, wr = wid >> 2, wc = wid & 3, fr = lane & 15, fq = lane >> 4;
    const int K = g.K, nt = K / BK;
    unsigned voffA[2], voffB[2];
#pragma unroll
    for (int i = 0; i < 2; ++i) { int R, C; stage_rc(tid * 16 + i * 8192, R, C); const int Rb = Epi::PERM ? ((R & ~31) + perm32(R & 31)) : R;
        voffA[i] = g.amode ? (unsigned)(R * 16 + (C >> 3) * 32768) : (unsigned)(R * K + C) * 2u; voffB[i] = (unsigned)(Rb * K + C) * 2u; }
    const size_t kstep = (size_t)(BK * 2);
    const size_t hstep = (size_t)HALF * K * 2;
    const size_t tstep = 2 * hstep;
    const size_t kstepA = g.amode ? (size_t)262144 : kstep, hstepA = g.amode ? (size_t)2048 : hstep;
    auto tileA = [&](int pm) -> const char* { return g.amode ? (const char*)g.A + (size_t)(pm >> 3) * 2097152 + (size_t)(pm & 7) * 4096 : (const char*)g.A + (size_t)pm * tstep; };
    const unsigned ldsw = (unsigned)wid * 1024u;
    const int aoff = lds_byte(wr * 64 + fr, fq * 8), boff = lds_byte(wc * 32 + fr, fq * 8);
#define PG8_SA(b, h) (((b) * 2 + (h)) * HTB)
#define PG8_SB(b, h) ((4 + (b) * 2 + (h)) * HTB)
#define PG8_STAGE(bufoff, gbase, voff) do { _Pragma("unroll") for (int _i = 0; _i < 2; ++_i) \
        __builtin_amdgcn_global_load_lds((const unsigned*)((const char*)(gbase) + (voff)[_i]), (PG8_LAS unsigned*)(lds + (bufoff) + ldsw + _i * 8192), 16, 0, 0); } while (0)
#define PG8_LD8(p) __builtin_shufflevector(*(const PG8_LAS v4i_t*)(p), *(const PG8_LAS v4i_t*)((p) + 1024), 0, 1, 2, 3, 4, 5, 6, 7)
#define PG8_LDA(dst, b, h) do { if constexpr (FP8) { _Pragma("unroll") for (int m = 0; m < 4; ++m) dst##8[m] = PG8_LD8(lds + PG8_SA(b, h) + aoff + m * 2048); } \
        else { _Pragma("unroll") for (int m = 0; m < 4; ++m) _Pragma("unroll") for (int k = 0; k < 2; ++k) dst[m][k] = *(const PG8_LAS bf16x8*)(lds + PG8_SA(b, h) + aoff + m * 2048 + k * 1024); } } while (0)
#define PG8_LDB(dst, b, h) do { if constexpr (FP8) { _Pragma("unroll") for (int n = 0; n < 2; ++n) dst##8[n] = PG8_LD8(lds + PG8_SB(b, h) + boff + n * 2048); } \
        else { _Pragma("unroll") for (int n = 0; n < 2; ++n) _Pragma("unroll") for (int k = 0; k < 2; ++k) dst[n][k] = *(const PG8_LAS bf16x8*)(lds + PG8_SB(b, h) + boff + n * 2048 + k * 1024); } } while (0)
#define PG8_CAT8(x0, x1) __builtin_shufflevector(__builtin_bit_cast(v4i_t, (x0)), __builtin_bit_cast(v4i_t, (x1)), 0, 1, 2, 3, 4, 5, 6, 7)
#define PG8_MMA(ai, bj, At, Bt) do { __builtin_amdgcn_s_setprio(1); if constexpr (FP8) asm volatile("s_nop 1" ::: "memory"); _Pragma("unroll") for (int m = 0; m < 4; ++m) _Pragma("unroll") for (int n = 0; n < 2; ++n) { \
        if constexpr (FP8) asm volatile("v_mfma_f32_16x16x128_f8f6f4 %0, %1, %2, %0" : "+v"(acc[ai][bj][m][n]) : "v"(Bt##8[n]), "v"(At##8[m])); \
        else { _Pragma("unroll") for (int k = 0; k < 2; ++k) acc[ai][bj][m][n] = __builtin_amdgcn_mfma_f32_16x16x32_bf16(Bt[n][k], At[m][k], acc[ai][bj][m][n], 0, 0, 0); } } \
        __builtin_amdgcn_s_setprio(0); } while (0)
#define PG8_WAIT_V(n) asm volatile("s_waitcnt vmcnt(" #n ")" ::: "memory")
#define PG8_WAIT_L(n) asm volatile("s_waitcnt lgkmcnt(" #n ")" ::: "memory")
#define PG8_BAR __builtin_amdgcn_s_barrier()
#define PG8_SCHED __builtin_amdgcn_sched_barrier(0)
    Unit cur, nxt; int ui = 0;
    if (!S.next(0, cur)) return;
    f32x4 acc[2][2][4][2];
#pragma unroll
    for (int a = 0; a < 2; ++a)
#pragma unroll
        for (int b = 0; b < 2; ++b)
#pragma unroll
            for (int m = 0; m < 4; ++m)
#pragma unroll
                for (int n = 0; n < 2; ++n) acc[a][b][m][n] = (f32x4){0.f, 0.f, 0.f, 0.f};
    bf16x8 At[4][2], B0[2][2], B1[2][2]; v8i_t At8[4], B08[2], B18[2];
    const char* cA = tileA(cur.pm); const char* cB = (const char*)g.Bt + (size_t)cur.pn * tstep;
    S.a_ready(cur);
    if constexpr (SP2) {
        PG8_STAGE(PG8_SB(0, 0), cB, voffB); PG8_STAGE(PG8_SB(0, 1), cB + hstep, voffB); PG8_STAGE(PG8_SA(0, 0), cA, voffA); PG8_STAGE(PG8_SA(0, 1), cA + hstepA, voffA);
        if (wr == 1) PG8_BAR;
        PG8_WAIT_V(2); PG8_BAR;
        PG8_STAGE(PG8_SB(1, 0), cB + kstep, voffB); PG8_STAGE(PG8_SA(1, 0), cA + kstepA, voffA); PG8_STAGE(PG8_SB(1, 1), cB + hstep + kstep, voffB);
        PG8_WAIT_V(6); PG8_BAR;
    } else {
        PG8_STAGE(PG8_SB(0, 0), cB, voffB); PG8_STAGE(PG8_SA(0, 0), cA, voffA); PG8_STAGE(PG8_SB(0, 1), cB + hstep, voffB); PG8_STAGE(PG8_SA(0, 1), cA + hstepA, voffA);
        if (wr == 1) PG8_BAR;
        PG8_WAIT_V(4); PG8_BAR;
        PG8_STAGE(PG8_SB(1, 0), cB + kstep, voffB); PG8_STAGE(PG8_SA(1, 0), cA + kstepA, voffA); PG8_STAGE(PG8_SB(1, 1), cB + hstep + kstep, voffB);
        PG8_WAIT_V(6); PG8_BAR;
    }
    for (;;) {
        const bool has_next = S.next(ui + 1, nxt);
        const char* nA = has_next ? tileA(nxt.pm) : cA; const char* nB = has_next ? (const char*)g.Bt + (size_t)nxt.pn * tstep : cB;
        for (int t = 0; t < nt; t += 2) {
            const bool last = (t == nt - 2);
            const char* a1 = cA + (size_t)(t + 1) * kstepA;
            const char* a2 = last ? nA : cA + (size_t)(t + 2) * kstepA; const char* b2 = last ? nB : cB + (size_t)(t + 2) * kstep;
            const char* a3 = a2 + kstepA; const char* b3 = b2 + kstep;
            if (last && has_next) S.a_ready(nxt);
            if constexpr (SP2) {
            PG8_LDB(B0, 0, 0); PG8_LDB(B1, 0, 1); PG8_SCHED; PG8_LDA(At, 0, 0); PG8_STAGE(PG8_SA(1, 1), a1 + hstepA, voffA);
            PG8_WAIT_V(8); PG8_WAIT_L(0); PG8_BAR; PG8_MMA(0, 0, At, B0); PG8_MMA(0, 1, At, B1); PG8_BAR; PG8_SCHED;
            PG8_LDA(At, 0, 1); PG8_STAGE(PG8_SB(0, 0), b2, voffB); PG8_STAGE(PG8_SB(0, 1), b2 + hstep, voffB); PG8_STAGE(PG8_SA(0, 0), a2, voffA);
            PG8_WAIT_V(8); PG8_WAIT_L(0); PG8_BAR; PG8_MMA(1, 0, At, B0); PG8_MMA(1, 1, At, B1); PG8_BAR; PG8_SCHED;
            PG8_LDB(B0, 1, 0); PG8_LDB(B1, 1, 1); PG8_SCHED; PG8_LDA(At, 1, 0); PG8_STAGE(PG8_SA(0, 1), a2 + hstepA, voffA);
            PG8_WAIT_V(8); PG8_WAIT_L(0); PG8_BAR; PG8_MMA(0, 0, At, B0); PG8_MMA(0, 1, At, B1); PG8_BAR; PG8_SCHED;
            PG8_LDA(At, 1, 1); PG8_STAGE(PG8_SB(1, 0), b3, voffB); PG8_STAGE(PG8_SB(1, 1), b3 + hstep, voffB); PG8_STAGE(PG8_SA(1, 0), a3, voffA);
            PG8_WAIT_V(8); PG8_WAIT_L(0); PG8_BAR; PG8_MMA(1, 0, At, B0); PG8_MMA(1, 1, At, B1); PG8_BAR; PG8_SCHED;
            } else {
            PG8_LDB(B0, 0, 0); PG8_SCHED; PG8_LDA(At, 0, 0); PG8_STAGE(PG8_SA(1, 1), a1 + hstepA, voffA);
            PG8_WAIT_L(8); PG8_BAR; PG8_WAIT_L(0); PG8_MMA(0, 0, At, B0); PG8_BAR; PG8_SCHED;
            PG8_LDB(B1, 0, 1); PG8_STAGE(PG8_SB(0, 0), b2, voffB);
            PG8_BAR; PG8_WAIT_L(0); PG8_MMA(0, 1, At, B1); PG8_BAR;
            PG8_LDA(At, 0, 1); PG8_STAGE(PG8_SA(0, 0), a2, voffA);
            PG8_BAR; PG8_WAIT_L(0); PG8_MMA(1, 0, At, B0); PG8_BAR; PG8_SCHED;
            PG8_STAGE(PG8_SB(0, 1), b2 + hstep, voffB);
            PG8_WAIT_V(6); PG8_BAR; PG8_MMA(1, 1, At, B1); PG8_BAR;
            PG8_LDB(B0, 1, 0); PG8_SCHED; PG8_LDA(At, 1, 0); PG8_STAGE(PG8_SA(0, 1), a2 + hstepA, voffA);
            PG8_WAIT_L(8); PG8_BAR; PG8_WAIT_L(0); PG8_MMA(0, 0, At, B0); PG8_BAR; PG8_SCHED;
            PG8_LDB(B1, 1, 1); PG8_STAGE(PG8_SB(1, 0), b3, voffB);
            PG8_BAR; PG8_WAIT_L(0); PG8_MMA(0, 1, At, B1); PG8_BAR;
            PG8_LDA(At, 1, 1); PG8_STAGE(PG8_SA(1, 0), a3, voffA);
            PG8_BAR; PG8_WAIT_L(0); PG8_MMA(1, 0, At, B0); PG8_BAR; PG8_SCHED;
            PG8_STAGE(PG8_SB(1, 1), b3 + hstep, voffB);
            PG8_WAIT_V(6); PG8_BAR; PG8_MMA(1, 1, At, B1); PG8_BAR;
            }
        }
        if constexpr (ALIGN_EPI) { if (wr == 0) PG8_BAR; }
        if constexpr (!Epi::AFTER_DRAIN) { E(acc, cur, wr, wc, fr, fq); S.done(cur); }
        if (!has_next) break;
#pragma unroll
        for (int a = 0; a < 2; ++a)
#pragma unroll
            for (int b = 0; b < 2; ++b)
#pragma unroll
                for (int m = 0; m < 4; ++m)
#pragma unroll
                    for (int n = 0; n < 2; ++n) acc[a][b][m][n] = (f32x4){0.f, 0.f, 0.f, 0.f};
        cur = nxt; cA = nA; cB = nB; ++ui;
        if constexpr (ALIGN_EPI) { if (wr == 1) PG8_BAR; }
    }
    PG8_WAIT_V(0);
    if constexpr (!ALIGN_EPI) { if (wr == 0) PG8_BAR; }
    PG8_BAR;
    if constexpr (Epi::AFTER_DRAIN) { E.fused(acc, cur, wr, wc, fr, fq, lds, wid, lane); S.done(cur); }
#undef PG8_SA
#undef PG8_SB
#undef PG8_STAGE
#undef PG8_LDA
#undef PG8_LDB
#undef PG8_MMA
#undef PG8_WAIT_V
#undef PG8_WAIT_L
#undef PG8_BAR
#undef PG8_SCHED
}
}
constexpr size_t MiB = 1u << 20;
constexpr size_t WS_CTL = 0, CTL_ZERO_BYTES = 1 * MiB;
constexpr size_t WS_WIN = 2 * MiB, WS_WAO = 34 * MiB, WS_WGLU = 42 * MiB, WS_WOUT = 50 * MiB, WS_WPQ = 58 * MiB;
constexpr size_t WS_SSM = 66 * MiB;
constexpr size_t WS_IDX = 106 * MiB, WS_GATE = 122 * MiB, WS_SSQ = 138 * MiB;
constexpr size_t WS_BUFA = 144 * MiB, WS_BUFB = 272 * MiB, WS_YACT = 400 * MiB;
constexpr size_t WS_Q = 464 * MiB, WS_KV = 592 * MiB, WS_U = 656 * MiB, WS_GT = 720 * MiB;
constexpr size_t WS_DOWNB = 720 * MiB, WS_UPB = 784 * MiB;
constexpr size_t WS_END = 980 * MiB;
constexpr size_t WS_W8 = 272 * MiB + 64 * MiB, WS_HS = 102 * MiB;
constexpr size_t WS_H8 = WS_BUFB;
constexpr int CW_AMAX = 131072;
constexpr size_t WS_WAO8 = 91 * MiB, WS_WGLU8 = 95 * MiB;
constexpr int CW_AMAX_AO = CW_AMAX + 8192, CW_AMAX_GLU = CW_AMAX + 8192 + 2048, CW_AMAX_OUT = CW_AMAX + 8192 + 2048 + 4096;
constexpr float O8_SCALE = 64.f, Y8_SCALE = 16.f, M8_SCALE = 64.f;
constexpr size_t WS_WOUT8 = 976 * MiB;
constexpr int CW_BAR = 4096;

constexpr int RING_OFF = 0, RING_BYTES = 131072;
constexpr int LDS_BYTES = 163840;
constexpr int LDSCTL_OFF = LDS_BYTES - 1024, MISC_OFF = LDSCTL_OFF + 320;
constexpr int NWAVES = 8;

#define XB_TMO      128
#define XB_XCNT(j)  (256  + 64 * (j))
#define XB_XSUB(j)  (1280 + 64 * (j))
#define XB_XGEN(j)  (2304 + 64 * (j))
#define XB_TOP      3328
#define XB_TOPGEN   3392
#define XCD_BAR_WORDS 3456
#define XB_SPIN_CAP (1u << 23)

__device__ __forceinline__ unsigned xb_ld(unsigned* p)              { return __hip_atomic_load(p, __ATOMIC_RELAXED, __HIP_MEMORY_SCOPE_AGENT); }
__device__ __forceinline__ unsigned xb_add(unsigned* p, unsigned v) { return __hip_atomic_fetch_add(p, v, __ATOMIC_RELAXED, __HIP_MEMORY_SCOPE_AGENT); }
__device__ __forceinline__ unsigned xb_xcc_id() { return (unsigned)__builtin_amdgcn_s_getreg((3 << 11) | 20) & 0xFu; }
#define XB_SPIN(cond, bar) do { unsigned _sp = 0; while (cond) { __builtin_amdgcn_s_sleep(1); \
    if ((++_sp & 255u) == 0u) { if (xb_ld(&(bar)[XB_TMO])) break; if (_sp > XB_SPIN_CAP) { atomicAdd(&(bar)[XB_TMO], 1u); break; } } } } while (0)

struct XcdBarrier {
    unsigned* bar; unsigned x;
    volatile LAS unsigned* st;
};

__device__ __forceinline__ XcdBarrier xcd_barrier_post(unsigned* bar, volatile LAS unsigned* st) {
    XcdBarrier b; b.bar = bar; b.x = xb_xcc_id(); b.st = st;
    if (threadIdx.x == 0) (void)xb_add(&bar[XB_XCNT(b.x)], 1u);
    return b;
}
__device__ __forceinline__ void xcd_barrier_complete(unsigned* bar, unsigned x, unsigned& nloc, unsigned& nx) {
    const unsigned G = gridDim.x * gridDim.y * gridDim.z;
    unsigned sum, cnt, mine, sp = 0u;
    for (;;) {
        sum = 0u; cnt = 0u; mine = 0u;
#pragma unroll
        for (unsigned j = 0; j < 16; ++j) { const unsigned c = xb_ld(&bar[XB_XCNT(j)]); sum += c; cnt += (c > 0u) ? 1u : 0u; mine = (j == x) ? c : mine; }
        if (sum == G) break;
        __builtin_amdgcn_s_sleep(1);
        if ((++sp & 255u) == 0u) { if (xb_ld(&bar[XB_TMO])) break; if (sp > XB_SPIN_CAP) { atomicAdd(&bar[XB_TMO], 1u); break; } }
    }
    nloc = mine > 0u ? mine : 1u; nx = cnt > 0u ? cnt : 1u;
}

__device__ __forceinline__ void xcd_barrier(const XcdBarrier& b) {
    asm volatile("s_waitcnt vmcnt(0)" ::: "memory");
    __syncthreads();
    if (threadIdx.x == 0) {
        unsigned* bar = b.bar;
        __builtin_amdgcn_s_waitcnt(0);
        unsigned nloc = b.st[0], nx = b.st[1];
        if (nloc == 0u) { xcd_barrier_complete(bar, b.x, nloc, nx); b.st[0] = nloc; b.st[1] = nx; }
        const unsigned old = xb_add(&bar[XB_XSUB(b.x)], 1u);
        const unsigned gen = old / nloc;
        if (old + 1u == (gen + 1u) * nloc) {
            __builtin_amdgcn_fence(__ATOMIC_RELEASE, "agent");
            asm volatile("s_waitcnt vmcnt(0)" ::: "memory");
            const unsigned og = xb_add(&bar[XB_TOP], 1u);
            const unsigned tg = og / nx;
            if (og + 1u == (tg + 1u) * nx) xb_add(&bar[XB_TOPGEN], 1u);
            else XB_SPIN(xb_ld(&bar[XB_TOPGEN]) == tg, bar);
            __builtin_amdgcn_fence(__ATOMIC_ACQUIRE, "agent");
            xb_add(&bar[XB_XGEN(b.x)], 1u);
            asm volatile("s_waitcnt vmcnt(0)" ::: "memory");
        } else {
            XB_SPIN(xb_ld(&bar[XB_XGEN(b.x)]) == gen, bar);
            __builtin_amdgcn_fence(__ATOMIC_ACQUIRE, "agent");
            asm volatile("s_waitcnt vmcnt(0)" ::: "memory");
        }
    }
    __syncthreads();
}

#define XB_ALIGN(j) (3520 + 64 * (j))
__device__ __forceinline__ void xcd_align(const XcdBarrier& b) {
    __syncthreads();
    if (threadIdx.x == 0) {
        unsigned nloc = b.st[0]; if (nloc == 0u) nloc = 1u;
        unsigned* ctr = &b.bar[XB_ALIGN(b.x)];
        const unsigned old = xb_add(ctr, 1u); const unsigned target = (old / nloc + 1u) * nloc;
        unsigned sp = 0; while (xb_ld(ctr) < target) { __builtin_amdgcn_s_sleep(1); if (++sp > (1u << 20)) break; }
    }
    __syncthreads();
}
struct Frame {
    LAS unsigned char* lds;
    volatile LAS unsigned* MISC;
    gu32* ctl;
    int tid, lane, wave;
    int vcu, G;
    const float* const* in; float* out; unsigned char* ws;
};
#define IN_X 0
#define IN_MIXG 1
#define IN_WIN 2
#define IN_QG 3
#define IN_KG 4
#define IN_SINK 5
#define IN_WAO 6
#define IN_ARE 7
#define IN_AIM 8
#define IN_LSTEP 9
#define IN_BRE 10
#define IN_BIM 11
#define IN_CRE 12
#define IN_CIM 13
#define IN_SSMD 14
#define IN_GLUA 15
#define IN_GLUB 16
#define IN_WOUT 17
#define IN_FFNG 18
#define IN_PWQ 19
#define IN_SK1 20
#define IN_SK2 21
#define IN_PDOWN 22
#define IN_PUP 23

__device__ __forceinline__ int glu_row(int j, int isb) { return 256 * (j >> 7) + 128 * isb + (j & 127); }
__device__ __forceinline__ void p0_transpose_item(const float* W, int K, int N, bf16* WT, int mode, const float* gk, LAS float* scr, int item, int lane, unsigned* amaxw = nullptr, int amax_col0 = 0) {
    const int nblk = N / 32, kb = item / nblk, nb = item % nblk, k0 = 64 * kb, n0 = 32 * nb;
#pragma unroll 8
    for (int i = 0; i < 32; ++i) { const int kk = 2 * i + (lane >> 5); float w = __builtin_nontemporal_load(W + (size_t)(k0 + kk) * N + n0 + (lane & 31)); if (gk) w *= gk[k0 + kk]; scr[kk * 33 + (lane & 31)] = w; }
    LDS_WAIT(); asm volatile("" ::: "memory");
    const int c = lane & 7;
#pragma unroll
    for (int j = 0; j < 4; ++j) { const int n = (lane >> 3) + 8 * j; const LAS float* s = scr + (8 * c) * 33 + n;
        v4u o; o.x = pk2(s[0 * 33], s[1 * 33]); o.y = pk2(s[2 * 33], s[3 * 33]); o.z = pk2(s[4 * 33], s[5 * 33]); o.w = pk2(s[6 * 33], s[7 * 33]);
        const int sc = n0 + n, drow = (mode == 0) ? sc : glu_row(sc, mode - 1);
        *(GAS v4u*)(WT + (size_t)drow * K + k0 + 8 * c) = o;
        if (amaxw) {
            float mx = fmaxf(fmaxf(fmaxf(fabsf(s[0 * 33]), fabsf(s[1 * 33])), fmaxf(fabsf(s[2 * 33]), fabsf(s[3 * 33]))), fmaxf(fmaxf(fabsf(s[4 * 33]), fabsf(s[5 * 33])), fmaxf(fabsf(s[6 * 33]), fabsf(s[7 * 33]))));
            mx = fmaxf(mx, __shfl_xor(mx, 1)); mx = fmaxf(mx, __shfl_xor(mx, 2)); mx = fmaxf(mx, __shfl_xor(mx, 4));
            if (c == 0) atomicMax(amaxw + (drow - amax_col0), __float_as_uint(mx)); } }
    LDS_WAIT(); asm volatile("" ::: "memory");
}
__device__ __forceinline__ void rms_row_to_bf16(int lane, const float* xrow, const float* g, bf16* orow, unsigned char* o8row, float* hs) {
    const GAS f32x4* xr = (const GAS f32x4*)xrow + lane; const GAS f32x4* gr = (const GAS f32x4*)g + lane;
    f32x4 v[8]; float s = 0.f;
#pragma unroll
    for (int j = 0; j < 8; ++j) { v[j] = xr[64 * j]; s += (v[j].x * v[j].x + v[j].y * v[j].y) + (v[j].z * v[j].z + v[j].w * v[j].w); }
    const float rs = 1.0f / sqrtf(wave_sum(s) * (1.f / D_MODEL) + RMS_EPS);
    (void)orow;
    float amax = 0.f;
#pragma unroll
    for (int j = 0; j < 8; ++j) { const f32x4 gg = gr[64 * j]; v[j] = f32x4{v[j].x * rs * gg.x, v[j].y * rs * gg.y, v[j].z * rs * gg.z, v[j].w * rs * gg.w};
        amax = fmaxf(amax, fmaxf(fmaxf(fabsf(v[j].x), fabsf(v[j].y)), fmaxf(fabsf(v[j].z), fabsf(v[j].w)))); }
    amax = wave_max(amax); const float inv = amax > 0.f ? 448.f / amax : 0.f;
    if (lane == 0) *hs = amax * (1.f / 448.f);
#pragma unroll
    for (int j = 0; j < 8; ++j) { int q = 0; q = __builtin_amdgcn_cvt_pk_fp8_f32(v[j].x * inv, v[j].y * inv, q, false); q = __builtin_amdgcn_cvt_pk_fp8_f32(v[j].z * inv, v[j].w * inv, q, true);
        *(unsigned*)(o8row + 256 * j + 4 * lane) = (unsigned)q; }
}
__device__ __forceinline__ void p0_prologue(Frame& F, const int parts = 3) {
    LAS float* scr = (LAS float*)(F.lds + RING_OFF + F.wave * 16384);
    const int gw = F.vcu * NWAVES + F.wave, NGW = F.G * NWAVES;
    constexpr int I_IN = (2048 / 64) * (8192 / 32), I_SQ = (2048 / 64) * (2048 / 32), I_GL = (1024 / 64) * (2048 / 32);
    constexpr int NITEMS = I_IN + 3 * I_SQ + 2 * I_GL;
    unsigned char* ws = F.ws;
    if (parts & 1) for (int it = gw; it < NITEMS; it += NGW) {
        int r = it;
        if (r < I_IN) { p0_transpose_item(F.in[IN_WIN], 2048, 8192, (bf16*)(ws + WS_WIN), 0, nullptr, scr, r, F.lane, (unsigned*)F.ctl + CW_AMAX, 0); continue; } r -= I_IN;
        if (r < I_SQ) { p0_transpose_item(F.in[IN_WAO], 2048, 2048, (bf16*)(ws + WS_WAO), 0, nullptr, scr, r, F.lane, (unsigned*)F.ctl + CW_AMAX_AO, 0); continue; } r -= I_SQ;
        if (r < I_SQ) { p0_transpose_item(F.in[IN_WOUT], 2048, 2048, (bf16*)(ws + WS_WOUT), 0, nullptr, scr, r, F.lane, (unsigned*)F.ctl + CW_AMAX_OUT, 0); continue; } r -= I_SQ;
        if (r < I_SQ) { p0_transpose_item(F.in[IN_PWQ], 2048, 2048, (bf16*)(ws + WS_WPQ), 0, F.in[IN_FFNG], scr, r, F.lane); continue; } r -= I_SQ;
        if (r < I_GL) { p0_transpose_item(F.in[IN_GLUA], 1024, 2048, (bf16*)(ws + WS_WGLU), 1, nullptr, scr, r, F.lane, (unsigned*)F.ctl + CW_AMAX_GLU, 0); continue; } r -= I_GL;
        p0_transpose_item(F.in[IN_GLUB], 1024, 2048, (bf16*)(ws + WS_WGLU), 2, nullptr, scr, r, F.lane, (unsigned*)F.ctl + CW_AMAX_GLU, 0);
    }
    bf16* H = (bf16*)(ws + WS_BUFA);
    if (parts & 2) for (int m = gw; m < T_TOK; m += NGW) rms_row_to_bf16(F.lane, F.in[IN_X] + (size_t)m * D_MODEL, F.in[IN_MIXG], H + (size_t)m * D_MODEL, F.ws + WS_H8 + (size_t)m * D_MODEL, (float*)(F.ws + WS_HS) + m);
}

__device__ __forceinline__ void w8_convert_one(Frame& F, const v4u* WT, v2u* W8, const float* AMAX, size_t n8, int shift) {
    const size_t gt = (size_t)F.vcu * 512 + F.tid, NT = (size_t)F.G * 512;
    for (size_t i = gt; i < n8; i += NT) { const float am = AMAX[i >> shift], inv = am > 0.f ? 440.f / am : 0.f; const v4u w = WT[i];
        int q0 = 0, q1 = 0; q0 = __builtin_amdgcn_cvt_pk_fp8_f32(bflo(w.x) * inv, bfhi(w.x) * inv, q0, false); q0 = __builtin_amdgcn_cvt_pk_fp8_f32(bflo(w.y) * inv, bfhi(w.y) * inv, q0, true);
        q1 = __builtin_amdgcn_cvt_pk_fp8_f32(bflo(w.z) * inv, bfhi(w.z) * inv, q1, false); q1 = __builtin_amdgcn_cvt_pk_fp8_f32(bflo(w.w) * inv, bfhi(w.w) * inv, q1, true);
        W8[i] = v2u{(unsigned)q0, (unsigned)q1}; }
}
__device__ __forceinline__ void w8_convert_phase(Frame& F) {
    const float* AM = (const float*)((unsigned*)F.ctl);
    w8_convert_one(F, (const v4u*)(F.ws + WS_WIN), (v2u*)(F.ws + WS_W8), AM + CW_AMAX, (size_t)8192 * 2048 / 8, 8);
    w8_convert_one(F, (const v4u*)(F.ws + WS_WAO), (v2u*)(F.ws + WS_WAO8), AM + CW_AMAX_AO, (size_t)2048 * 2048 / 8, 8);
    w8_convert_one(F, (const v4u*)(F.ws + WS_WGLU), (v2u*)(F.ws + WS_WGLU8), AM + CW_AMAX_GLU, (size_t)4096 * 1024 / 8, 7);
    w8_convert_one(F, (const v4u*)(F.ws + WS_WOUT), (v2u*)(F.ws + WS_WOUT8), AM + CW_AMAX_OUT, (size_t)2048 * 2048 / 8, 8);
}

namespace ssm {
using bf16x8 = __attribute__((ext_vector_type(8))) short;
using f32x16 = __attribute__((ext_vector_type(16))) float;
constexpr size_t WS_FR1 = WS_SSM, WS_FR3 = WS_SSM + 8 * MiB, WS_SC = WS_SSM + 24 * MiB;
constexpr int CHS = 528, L_U = 0, L_XZ = 128 * CHS;
typedef float cf __attribute__((ext_vector_type(2)));
__device__ __forceinline__ cf cmul(cf a, cf b) { return cf{a.x * b.x - a.y * b.y, a.x * b.y + a.y * b.x}; }
__device__ __forceinline__ void precompute_group(Frame& F, int g, int part) {
    LAS cf* POW = (LAS cf*)(F.lds);
    LAS cf* BB = (LAS cf*)(F.lds + 17408);
    LAS cf* CC = (LAS cf*)(F.lds + 33792);
    LAS float* KT = (LAS float*)(F.lds + 50176);
    const int tid = F.tid;
    for (int idx = tid; idx < 2 * 17 * 64; idx += 512) { const int dir = idx / (17 * 64), d = (idx >> 6) % 17, n = idx & 63, pg = dir * 64 + g;
        const float are = F.in[IN_ARE][pg * 64 + n], aim = F.in[IN_AIM][pg * 64 + n], step = expf(F.in[IN_LSTEP][pg]);
        const float mag = expf((float)d * are * step), ang = (float)d * aim * step; POW[idx] = cf{mag * cosf(ang), mag * sinf(ang)}; }
    for (int idx = tid; idx < 2 * 64 * 16; idx += 512) { const int dir = idx >> 10, n = (idx >> 4) & 63, c = idx & 15, pg = dir * 64 + g;
        const float are = F.in[IN_ARE][pg * 64 + n], aim = F.in[IN_AIM][pg * 64 + n], step = expf(F.in[IN_LSTEP][pg]);
        const float mag = expf(are * step), ang = aim * step; const float lr = mag * cosf(ang), li = mag * sinf(ang);
        const float nr = lr - 1.f, ni = li, den = are * are + aim * aim; const cf f{(nr * are + ni * aim) / den, (ni * are - nr * aim) / den};
        BB[idx] = cmul(f, cf{F.in[IN_BRE][((size_t)pg * 64 + n) * 16 + c], F.in[IN_BIM][((size_t)pg * 64 + n) * 16 + c]}); }
    for (int idx = tid; idx < 2 * 16 * 64; idx += 512) { const int dir = idx >> 10, pg = dir * 64 + g; CC[idx] = cf{F.in[IN_CRE][(size_t)pg * 1024 + (idx & 1023)], F.in[IN_CIM][(size_t)pg * 1024 + (idx & 1023)]}; }
    LDS_WAIT(); __syncthreads();
    { const int dir = tid >> 8, d = (tid >> 4) & 15, c = tid & 15; float s[16];
#pragma unroll
      for (int c2 = 0; c2 < 16; ++c2) s[c2] = 0.f;
      for (int n = 0; n < 64; ++n) { const cf t = cmul(CC[(dir * 16 + c) * 64 + n], POW[(dir * 17 + d) * 64 + n]);
#pragma unroll
          for (int c2 = 0; c2 < 16; ++c2) { const cf b = BB[(dir * 64 + n) * 16 + c2]; s[c2] += t.x * b.x - t.y * b.y; } }
#pragma unroll
      for (int c2 = 0; c2 < 16; ++c2) KT[((dir * 16 + d) * 16 + c) * 16 + c2] = s[c2]; }
    LDS_WAIT(); __syncthreads();
    v4u* FR1 = (v4u*)(F.ws + WS_FR1); v4u* FR3 = (v4u*)(F.ws + WS_FR3); float* SC = (float*)(F.ws + WS_SC);
    for (int task = part * 2048 + tid; task < (part + 1) * 2048; task += 512) { const int h = task & 1, ks = (task >> 1) & 15, sg = task >> 5, dir = sg >> 7, n = (sg >> 1) & 63, ri = sg & 1;
        const cf pw = dir == 0 ? POW[(0 * 17 + (15 - ks)) * 64 + n] : POW[(1 * 17 + ks) * 64 + n]; float v[8];
#pragma unroll
        for (int i = 0; i < 8; ++i) { const cf x = cmul(pw, BB[(dir * 64 + n) * 16 + 8 * h + i]); v[i] = ri ? x.y : x.x; }
        v4u o; o.x = pk2(v[0], v[1]); o.y = pk2(v[2], v[3]); o.z = pk2(v[4], v[5]); o.w = pk2(v[6], v[7]);
        FR1[(((size_t)g * 8 + (sg >> 5)) * 16 + ks) * 64 + (sg & 31) + 32 * h] = o; }
    for (int task = part * 4096 + tid; task < (part + 1) * 4096; task += 512) { const int h = task & 1, ks = (task >> 1) & 31, rho = task >> 6, t = rho >> 4, c = rho & 15; float v[8];
        if (ks < 16) {
#pragma unroll
            for (int i = 0; i < 8; ++i) { const int sg = 16 * ks + 8 * h + i, dir = sg >> 7, n = (sg >> 1) & 63, ri = sg & 1;
                const cf pw = dir == 0 ? POW[(0 * 17 + (t + 1)) * 64 + n] : POW[(1 * 17 + (16 - t)) * 64 + n]; const cf x = cmul(CC[(dir * 16 + c) * 64 + n], pw); v[i] = ri ? -x.y : x.x; }
        } else { const int j = ks - 16;
#pragma unroll
            for (int i = 0; i < 8; ++i) { const int c2 = 8 * h + i; float x;
                if (j < t) x = KT[((0 * 16 + (t - j)) * 16 + c) * 16 + c2]; else if (j > t) x = KT[((1 * 16 + (j - t)) * 16 + c) * 16 + c2];
                else x = KT[((0 * 16 + 0) * 16 + c) * 16 + c2] + KT[((1 * 16 + 0) * 16 + c) * 16 + c2] + (c == c2 ? F.in[IN_SSMD][g * 16 + c] : 0.f);
                v[i] = x; } }
        v4u o; o.x = pk2(v[0], v[1]); o.y = pk2(v[2], v[3]); o.z = pk2(v[4], v[5]); o.w = pk2(v[6], v[7]);
        FR3[(((size_t)g * 8 + (rho >> 5)) * 32 + ks) * 64 + (rho & 31) + 32 * h] = o; }
    if (part == 0 && tid < 256) { const int sg = tid, dir = sg >> 7, n = (sg >> 1) & 63, ri = sg & 1; const cf L16 = POW[(dir * 17 + 16) * 64 + n];
        SC[((size_t)g * 256 + sg) * 2] = L16.x; SC[((size_t)g * 256 + sg) * 2 + 1] = ri ? L16.y : -L16.y; }
    LDS_WAIT(); __syncthreads();
}
__device__ __forceinline__ float dpp_swap1(float x) { return __builtin_bit_cast(float, __builtin_amdgcn_update_dpp(0, __builtin_bit_cast(int, x), 0xB1, 0xF, 0xF, true)); }
__device__ __forceinline__ void unit(Frame& F, int b, int g) {
    const int tid = F.tid, w = F.wave, lane = F.lane, r32 = lane & 31, hi = lane >> 5;
    LAS char* lds = (LAS char*)F.lds;
    const bf16* U = (const bf16*)(F.ws + WS_U); bf16* YA = (bf16*)(F.ws + WS_YACT);
#pragma unroll
    for (int i = 0; i < 8; ++i) { const int pc = tid + 512 * i, s = pc >> 1, hf = pc & 1;
        const v4u v = *(const v4u*)(U + ((size_t)(b * 64 + g) * SEQ + s) * 16 + 8 * hf);
        *(LAS v4u*)(lds + L_U + (s >> 4) * CHS + ((s & 15) * 16 + 8 * hf) * 2) = v; }
    if (tid < 128) { *(LAS unsigned short*)(lds + L_XZ + tid * 2) = 0; *(LAS unsigned short*)(lds + L_XZ + 127 * CHS + (128 + tid) * 2) = 0; }
    LDS_WAIT(); __syncthreads();
    f32x16 acc[4] = {};
    { const bf16x8* fr1 = (const bf16x8*)(F.ws + WS_FR1) + ((size_t)g * 8 + w) * 16 * 64 + lane;
      int cA[4];
#pragma unroll
      for (int mt = 0; mt < 4; ++mt) cA[mt] = (64 * ((r32 >> 2) & 1) + 16 * mt + (r32 & 3) + 4 * (r32 >> 3)) * CHS + hi * 16;
#pragma unroll
      for (int ks = 0; ks < 16; ++ks) { const bf16x8 bfr = fr1[ks * 64];
#pragma unroll
          for (int mt = 0; mt < 4; ++mt) { const bf16x8 afr = *(LAS const bf16x8*)(lds + L_U + cA[mt] + ks * 32); acc[mt] = __builtin_amdgcn_mfma_f32_32x32x16_bf16(afr, bfr, acc[mt], 0, 0, 0); } } }
    { const float* SC = (const float*)(F.ws + WS_SC) + ((size_t)g * 256 + 32 * w + r32) * 2; const float ca = SC[0], cb = SC[1];
      LAS char* xz = lds + L_XZ + (32 * w + r32) * 2;
      float x = 0.f;
      if (w < 4) {
#pragma unroll
          for (int mt = 0; mt < 4; ++mt)
#pragma unroll
              for (int r = 0; r < 16; ++r) x = ca * x + cb * dpp_swap1(x) + acc[mt][r];
          const float c = __shfl_xor(x, 32); x = hi ? c : 0.f;
#pragma unroll
          for (int mt = 0; mt < 4; ++mt)
#pragma unroll
              for (int r = 0; r < 16; ++r) { x = ca * x + cb * dpp_swap1(x) + acc[mt][r]; const int k = 64 * hi + 16 * mt + r;
                  if (k + 1 <= 127) *(LAS unsigned short*)(xz + (k + 1) * CHS) = (unsigned short)(pk2(x, 0.f) & 0xffffu); }
      } else {
#pragma unroll
          for (int mt = 3; mt >= 0; --mt)
#pragma unroll
              for (int r = 15; r >= 0; --r) x = ca * x + cb * dpp_swap1(x) + acc[mt][r];
          const float c = __shfl_xor(x, 32); x = hi ? 0.f : c;
#pragma unroll
          for (int mt = 3; mt >= 0; --mt)
#pragma unroll
              for (int r = 15; r >= 0; --r) { x = ca * x + cb * dpp_swap1(x) + acc[mt][r]; const int k = 64 * hi + 16 * mt + r;
                  if (k >= 1) *(LAS unsigned short*)(xz + (k - 1) * CHS) = (unsigned short)(pk2(x, 0.f) & 0xffffu); }
      } }
    LDS_WAIT(); __syncthreads();
#pragma unroll
    for (int nt = 0; nt < 4; ++nt) acc[nt] = f32x16{};
    { const bf16x8* fr3 = (const bf16x8*)(F.ws + WS_FR3) + ((size_t)g * 8 + w) * 32 * 64 + lane;
      int cB[4];
#pragma unroll
      for (int nt = 0; nt < 4; ++nt) cB[nt] = (32 * nt + r32) * CHS + hi * 16;
#pragma unroll
      for (int ks = 0; ks < 32; ++ks) { const bf16x8 afr = fr3[ks * 64]; const int base = (ks < 16 ? L_XZ : L_U) + (ks & 15) * 32;
#pragma unroll
          for (int nt = 0; nt < 4; ++nt) { const bf16x8 bfr = *(LAS const bf16x8*)(lds + base + cB[nt]); acc[nt] = __builtin_amdgcn_mfma_f32_32x32x16_bf16(afr, bfr, acc[nt], 0, 0, 0); } } }
#pragma unroll
    for (int nt = 0; nt < 4; ++nt)
#pragma unroll
        for (int rq = 0; rq < 4; ++rq) { const int t = 2 * w + (rq >> 1), c0 = 8 * (rq & 1) + 4 * hi; const size_t s = (size_t)(32 * nt + r32) * 16 + t;
            float y_[4];
#pragma unroll
            for (int e = 0; e < 4; ++e) y_[e] = fminf(fmaxf(gelu_erf(acc[nt][4 * rq + e]) * Y8_SCALE, -448.f), 448.f);
            int q = 0; q = __builtin_amdgcn_cvt_pk_fp8_f32(y_[0], y_[1], q, false); q = __builtin_amdgcn_cvt_pk_fp8_f32(y_[2], y_[3], q, true);
            *(unsigned*)((unsigned char*)YA + ((size_t)(b * 64 + g) * SEQ + s) * 16 + c0) = (unsigned)q; }
    LDS_WAIT(); __syncthreads();
}
}
__device__ __forceinline__ void ssm_mfma_phase(Frame& F) {
    for (int c = F.vcu; c < BATCH * SSM_G / 4; c += F.G)
        for (int u = 4 * c; u < 4 * c + 4; ++u) ssm::unit(F, u & 15, u >> 4);
}

namespace att {
using bf16x8 = __attribute__((ext_vector_type(8))) short;
using s16x4  = __attribute__((ext_vector_type(4))) short;
using f32x16 = __attribute__((ext_vector_type(16))) float;
using u32x4  = __attribute__((ext_vector_type(4))) unsigned;
constexpr int KVB = 64, SHM_V = KVB * 128 * 2, SHM_K = KVB * 128 * 2;
constexpr int L_V = 0, L_K = 2 * SHM_V, L_WS = 2 * SHM_V + 2 * SHM_K;
#define KSWZ(row, colB) ((row) * 256 + ((colB) ^ (((row) & 7) << 4)))
#define SBAR() __builtin_amdgcn_sched_barrier(0)
__device__ __forceinline__ int crow(int r, int hi) { return (r & 3) + 8 * (r >> 2) + 4 * hi; }
__device__ __forceinline__ int v_st(int k, int c) { const int kk = (k & ~0xC) | ((k & 4) << 1) | ((k & 8) >> 1); return ((kk >> 3) * 4 + (c >> 5)) * 512 + ((kk & 7) * 32 + (c & 31)) * 2; }
__device__ __forceinline__ int v_rd_base(int lane) { return ((lane & 3) << 3) | (((lane >> 2) & 3) << 6) | (((lane >> 4) & 1) << 5) | (((lane >> 5) & 1) << 8); }
constexpr int v_rd_off(int d0, int ks, int half) { return d0 * 512 + ks * 4096 + half * 2048; }
template <int OFF> __device__ __forceinline__ s16x4 tr_read(int vb) { s16x4 r; asm volatile("ds_read_b64_tr_b16 %0, %1 offset:%2" : "=&v"(r) : "v"(vb), "i"(OFF) : "memory"); return r; }
template <int D0> __device__ __forceinline__ void pv_one(f32x16& od, int vb, bf16x8 pa0, bf16x8 pa1, bf16x8 pa2, bf16x8 pa3) {
    const s16x4 l0 = tr_read<v_rd_off(D0, 0, 0)>(vb), h0 = tr_read<v_rd_off(D0, 0, 1)>(vb), l1 = tr_read<v_rd_off(D0, 1, 0)>(vb), h1 = tr_read<v_rd_off(D0, 1, 1)>(vb);
    const s16x4 l2 = tr_read<v_rd_off(D0, 2, 0)>(vb), h2 = tr_read<v_rd_off(D0, 2, 1)>(vb), l3 = tr_read<v_rd_off(D0, 3, 0)>(vb), h3 = tr_read<v_rd_off(D0, 3, 1)>(vb);
    asm volatile("s_waitcnt lgkmcnt(0)" ::: "memory"); SBAR();
#define PK(L, H) (bf16x8){L[0], L[1], L[2], L[3], H[0], H[1], H[2], H[3]}
    od = __builtin_amdgcn_mfma_f32_32x32x16_bf16(pa0, PK(l0, h0), od, 0, 0, 0);
    od = __builtin_amdgcn_mfma_f32_32x32x16_bf16(pa1, PK(l1, h1), od, 0, 0, 0);
    od = __builtin_amdgcn_mfma_f32_32x32x16_bf16(pa2, PK(l2, h2), od, 0, 0, 0);
    od = __builtin_amdgcn_mfma_f32_32x32x16_bf16(pa3, PK(l3, h3), od, 0, 0, 0);
#undef PK
}
template <int D0> __device__ __forceinline__ void pv_reads(s16x4 (&l)[4], s16x4 (&h)[4], int vb) {
    l[0] = tr_read<v_rd_off(D0, 0, 0)>(vb); h[0] = tr_read<v_rd_off(D0, 0, 1)>(vb); l[1] = tr_read<v_rd_off(D0, 1, 0)>(vb); h[1] = tr_read<v_rd_off(D0, 1, 1)>(vb);
    l[2] = tr_read<v_rd_off(D0, 2, 0)>(vb); h[2] = tr_read<v_rd_off(D0, 2, 1)>(vb); l[3] = tr_read<v_rd_off(D0, 3, 0)>(vb); h[3] = tr_read<v_rd_off(D0, 3, 1)>(vb);
}
__device__ __forceinline__ void pv_mma(f32x16& od, const s16x4 (&l)[4], const s16x4 (&h)[4], bf16x8 pa0, bf16x8 pa1, bf16x8 pa2, bf16x8 pa3) {
#define PK(L, H) (bf16x8){L[0], L[1], L[2], L[3], H[0], H[1], H[2], H[3]}
    od = __builtin_amdgcn_mfma_f32_32x32x16_bf16(pa0, PK(l[0], h[0]), od, 0, 0, 0);
    od = __builtin_amdgcn_mfma_f32_32x32x16_bf16(pa1, PK(l[1], h[1]), od, 0, 0, 0);
    od = __builtin_amdgcn_mfma_f32_32x32x16_bf16(pa2, PK(l[2], h[2]), od, 0, 0, 0);
    od = __builtin_amdgcn_mfma_f32_32x32x16_bf16(pa3, PK(l[3], h[3]), od, 0, 0, 0);
#undef PK
}
__device__ __forceinline__ void pv_all(f32x16 (&o)[4], int vb, bf16x8 pa0, bf16x8 pa1, bf16x8 pa2, bf16x8 pa3) {
    s16x4 la[4], ha[4], lb[4], hb[4];
    asm volatile("s_waitcnt lgkmcnt(0)" ::: "memory"); SBAR();
    pv_reads<0>(la, ha, vb);
    pv_reads<1>(lb, hb, vb); asm volatile("s_waitcnt lgkmcnt(8)" ::: "memory"); SBAR(); pv_mma(o[0], la, ha, pa0, pa1, pa2, pa3); SBAR();
    pv_reads<2>(la, ha, vb); asm volatile("s_waitcnt lgkmcnt(8)" ::: "memory"); SBAR(); pv_mma(o[1], lb, hb, pa0, pa1, pa2, pa3); SBAR();
    pv_reads<3>(lb, hb, vb); asm volatile("s_waitcnt lgkmcnt(8)" ::: "memory"); SBAR(); pv_mma(o[2], la, ha, pa0, pa1, pa2, pa3); SBAR();
    asm volatile("s_waitcnt lgkmcnt(0)" ::: "memory"); SBAR(); pv_mma(o[3], lb, hb, pa0, pa1, pa2, pa3);
}
__device__ __forceinline__ void qkt(f32x16& p0, f32x16& p1, LAS const char* Ks, const bf16x8* qr, int r32, int hi) {
    p0 = f32x16{}; p1 = f32x16{};
#pragma unroll
    for (int d0 = 0; d0 < 8; ++d0) { const int cb = (d0 * 16 + hi * 8) * 2;
        const bf16x8 b0 = *(LAS const bf16x8*)(Ks + KSWZ(r32, cb));
        const bf16x8 b1 = *(LAS const bf16x8*)(Ks + KSWZ(32 + r32, cb));
        p0 = __builtin_amdgcn_mfma_f32_32x32x16_bf16(b0, qr[d0], p0, 0, 0, 0);
        p1 = __builtin_amdgcn_mfma_f32_32x32x16_bf16(b1, qr[d0], p1, 0, 0, 0); }
}
__device__ __forceinline__ float sum16(float d) {
    d += __builtin_bit_cast(float, __builtin_amdgcn_update_dpp(0, __builtin_bit_cast(int, d), 0xB1, 0xF, 0xF, true));
    d += __builtin_bit_cast(float, __builtin_amdgcn_update_dpp(0, __builtin_bit_cast(int, d), 0x4E, 0xF, 0xF, true));
    d += __builtin_bit_cast(float, __builtin_amdgcn_update_dpp(0, __builtin_bit_cast(int, d), 0x141, 0xF, 0xF, true));
    d += __builtin_bit_cast(float, __builtin_amdgcn_update_dpp(0, __builtin_bit_cast(int, d), 0x140, 0xF, 0xF, true));
    return d;
}
constexpr float THR2 = 8.f;
__device__ __forceinline__ void attn_unit(Frame& F, int b, int kvh, int qb, int hp) {
    const int tid = F.tid, wid = F.wave, lane = F.lane, r32 = lane & 31, hi = lane >> 5, wq = wid & 3, h = kvh * 4 + 2 * hp + (wid >> 2);
    LAS char* lds = (LAS char*)F.lds;
    LAS float* wsf = (LAS float*)(lds + L_WS) + wid * 64; LAS float* li_l = wsf; LAS float* al_l = wsf + 32;
    const bf16* Q = (const bf16*)(F.ws + WS_Q); const bf16* KVp = (const bf16*)(F.ws + WS_KV); bf16* O = (bf16*)(F.ws + WS_BUFA);
    const int q0 = qb * 128, kbase = q0 - 128, jlo = (qb == 0) ? 2 : 0, jhi = (qb == 15) ? 4 : 6;
    const size_t rowb = (size_t)b * SEQ;
    bf16x8 qr[8];
    { const bf16* Qw = Q + (rowb + q0 + wq * 32 + r32) * 2048 + h * 128 + hi * 8; v4u raw[8]; float ss = 0.f;
#pragma unroll
      for (int d0 = 0; d0 < 8; ++d0) { raw[d0] = *(const v4u*)(Qw + d0 * 16);
          const float a0 = bflo(raw[d0].x), a1 = bfhi(raw[d0].x), a2 = bflo(raw[d0].y), a3 = bfhi(raw[d0].y), a4 = bflo(raw[d0].z), a5 = bfhi(raw[d0].z), a6 = bflo(raw[d0].w), a7 = bfhi(raw[d0].w);
          ss += (a0 * a0 + a1 * a1) + (a2 * a2 + a3 * a3) + (a4 * a4 + a5 * a5) + (a6 * a6 + a7 * a7); }
      { auto rr = __builtin_amdgcn_permlane32_swap(__float_as_uint(ss), __float_as_uint(ss), false, false); ss = __uint_as_float(rr[0]) + __uint_as_float(rr[1]); }
      const float rs = (1.0f / sqrtf(ss * (1.f / 128.f) + RMS_EPS)) * (0.08838834764831845f * 1.4426950408889634f);
#pragma unroll
      for (int d0 = 0; d0 < 8; ++d0) { const f32x4 g0 = *(const f32x4*)(F.in[IN_QG] + d0 * 16 + hi * 8), g1 = *(const f32x4*)(F.in[IN_QG] + d0 * 16 + hi * 8 + 4);
          u32x4 w; w.x = pk2(bflo(raw[d0].x) * rs * g0.x, bfhi(raw[d0].x) * rs * g0.y); w.y = pk2(bflo(raw[d0].y) * rs * g0.z, bfhi(raw[d0].y) * rs * g0.w);
          w.z = pk2(bflo(raw[d0].z) * rs * g1.x, bfhi(raw[d0].z) * rs * g1.y); w.w = pk2(bflo(raw[d0].w) * rs * g1.z, bfhi(raw[d0].w) * rs * g1.w);
          qr[d0] = __builtin_bit_cast(bf16x8, w); } }
    const int sr = tid >> 4, sc = (tid & 15) * 8, vst0 = v_st(sr, sc), vst1 = v_st(32 + sr, sc);
    const f32x4 gk0 = *(const f32x4*)(F.in[IN_KG] + sc), gk1 = *(const f32x4*)(F.in[IN_KG] + sc + 4);
    const int vb0 = (int)(uintptr_t)(lds + L_V) + v_rd_base(lane);
    v4u sv0, sv1, sk0, sk1;
#define SLOAD(j) do { const bf16* kp_ = KVp + (rowb + kbase + (j) * 64 + sr) * 1024 + kvh * 128 + sc; \
        sk0 = *(const v4u*)kp_; sk1 = *(const v4u*)(kp_ + 32 * 1024); sv0 = *(const v4u*)(kp_ + 512); sv1 = *(const v4u*)(kp_ + 32 * 1024 + 512); } while (0)
#define KNORM(kk) do { const float a0 = bflo(kk.x), a1 = bfhi(kk.x), a2 = bflo(kk.y), a3 = bfhi(kk.y), a4 = bflo(kk.z), a5 = bfhi(kk.z), a6 = bflo(kk.w), a7 = bfhi(kk.w); \
        const float ss_ = sum16((a0 * a0 + a1 * a1) + (a2 * a2 + a3 * a3) + (a4 * a4 + a5 * a5) + (a6 * a6 + a7 * a7)); const float rk_ = 1.0f / sqrtf(ss_ * (1.f / 128.f) + RMS_EPS); \
        kk.x = pk2(a0 * rk_ * gk0.x, a1 * rk_ * gk0.y); kk.y = pk2(a2 * rk_ * gk0.z, a3 * rk_ * gk0.w); kk.z = pk2(a4 * rk_ * gk1.x, a5 * rk_ * gk1.y); kk.w = pk2(a6 * rk_ * gk1.z, a7 * rk_ * gk1.w); } while (0)
#define SWRITE(bf) do { KNORM(sk0); KNORM(sk1); *(LAS v4u*)(lds + L_V + (bf) * SHM_V + vst0) = sv0; *(LAS v4u*)(lds + L_V + (bf) * SHM_V + vst1) = sv1; \
        *(LAS v4u*)(lds + L_K + (bf) * SHM_K + KSWZ(sr, sc * 2)) = sk0; *(LAS v4u*)(lds + L_K + (bf) * SHM_K + KSWZ(32 + sr, sc * 2)) = sk1; } while (0)
    const float LOG2E = 1.4426950408889634f;
    const float slope2 = exp2f(-0.5f * (float)(h + 1)) * LOG2E;
    float m_reg = F.in[IN_SINK][h] * LOG2E, l_reg = 1.f; f32x16 o[4] = {};
    const int q_rel = 128 + wq * 32 + r32, wlo = wq >> 1, whi = (wq >> 1) + 4;
    SLOAD(jlo); SWRITE(0); __syncthreads();
    for (int j = jlo; j < jhi; ++j) {
        const int bf = (j - jlo) & 1;
        if (j + 1 < jhi) SLOAD(j + 1);
        if (j >= wlo && j <= whi) {
            f32x16 p0, p1; qkt(p0, p1, lds + L_K + bf * SHM_K, qr, r32, hi);
            const int kt0 = 64 * j + 4 * hi;
#pragma unroll
            for (int r = 0; r < 16; ++r) { const int k0 = kt0 + (r & 3) + 8 * (r >> 2); int d0 = q_rel - k0; d0 = d0 < 0 ? -d0 : d0; int d1 = q_rel - k0 - 32; d1 = d1 < 0 ? -d1 : d1;
                p0[r] = (d0 <= WINDOW) ? p0[r] - slope2 * (float)d0 : -1e30f; p1[r] = (d1 <= WINDOW) ? p1[r] - slope2 * (float)d1 : -1e30f; }
            float pmax = p0[0];
#pragma unroll
            for (int r = 1; r < 16; ++r) pmax = fmaxf(pmax, p0[r]);
#pragma unroll
            for (int r = 0; r < 16; ++r) pmax = fmaxf(pmax, p1[r]);
            { auto rr = __builtin_amdgcn_permlane32_swap(__float_as_uint(pmax), __float_as_uint(pmax), false, false); pmax = fmaxf(__uint_as_float(rr[0]), __uint_as_float(rr[1])); }
            float alpha = 1.f;
            if (!__all(pmax - m_reg <= THR2)) { const float mn = fmaxf(m_reg, pmax); alpha = __builtin_amdgcn_exp2f(m_reg - mn); m_reg = mn; }
#pragma unroll
            for (int r = 0; r < 16; ++r) { p0[r] = __builtin_amdgcn_exp2f(p0[r] - m_reg); p1[r] = __builtin_amdgcn_exp2f(p1[r] - m_reg); }
            float ps = 0.f;
#pragma unroll
            for (int r = 0; r < 16; ++r) ps += p0[r] + p1[r];
            { auto rr = __builtin_amdgcn_permlane32_swap(__float_as_uint(ps), __float_as_uint(ps), false, false); ps = __uint_as_float(rr[0]) + __uint_as_float(rr[1]); }
            l_reg = l_reg * alpha + ps;
            bf16x8 pa0, pa1, pa2, pa3;
#define PK4(P, BASE, OUT) do { const unsigned a0_ = pk2(P[BASE + 0], P[BASE + 1]), a1_ = pk2(P[BASE + 2], P[BASE + 3]), b0_ = pk2(P[BASE + 4], P[BASE + 5]), b1_ = pk2(P[BASE + 6], P[BASE + 7]); \
        auto r0_ = __builtin_amdgcn_permlane32_swap(a0_, b0_, false, false); auto r1_ = __builtin_amdgcn_permlane32_swap(a1_, b1_, false, false); \
        u32x4 w_ = {r0_[0], r1_[0], r0_[1], r1_[1]}; OUT = __builtin_bit_cast(bf16x8, w_); } while (0)
            PK4(p0, 0, pa0); PK4(p0, 8, pa1); PK4(p1, 0, pa2); PK4(p1, 8, pa3);
#undef PK4
            if (__any(alpha < 1.f)) { if (hi == 0) al_l[r32] = alpha; asm volatile("s_waitcnt lgkmcnt(0)" ::: "memory");
#pragma unroll
                for (int d = 0; d < 4; ++d)
#pragma unroll
                    for (int r = 0; r < 16; ++r) o[d][r] *= al_l[crow(r, hi)]; }
            const int vb = vb0 + bf * SHM_V;
            pv_all(o, vb, pa0, pa1, pa2, pa3);
        }
        if (j + 1 < jhi) SWRITE(bf ^ 1);
        __syncthreads();
    }
    if (hi == 0) li_l[r32] = l_reg; asm volatile("s_waitcnt lgkmcnt(0)" ::: "memory");
    float rli[16];
#pragma unroll
    for (int r = 0; r < 16; ++r) rli[r] = __builtin_amdgcn_rcpf(li_l[crow(r, hi)]);
    LAS unsigned char* stg = (LAS unsigned char*)(lds + wid * 4096);
#pragma unroll
    for (int r = 0; r < 16; ++r) { const int orow = crow(r, hi); const float sc_ = rli[r] * O8_SCALE;
#pragma unroll
        for (int d0 = 0; d0 < 4; d0 += 2) { const float v0 = fminf(fmaxf(o[d0][r] * sc_, -448.f), 448.f), v1 = fminf(fmaxf(o[d0 + 1][r] * sc_, -448.f), 448.f);
            const int q = __builtin_amdgcn_cvt_pk_fp8_f32(v0, v1, 0, false);
            stg[orow * 128 + d0 * 32 + r32] = (unsigned char)(q & 0xff); stg[orow * 128 + (d0 + 1) * 32 + r32] = (unsigned char)((q >> 8) & 0xff); } }
    asm volatile("s_waitcnt lgkmcnt(0)" ::: "memory");
    unsigned char* Ow = (unsigned char*)O + (rowb + q0 + wq * 32) * 2048 + h * 128;
#pragma unroll
    for (int i = 0; i < 4; ++i) { const int row = i * 8 + (lane >> 3), ch = lane & 7; const v4u v = *(LAS const v4u*)(stg + row * 128 + ch * 16); *(v4u*)(Ow + (size_t)row * 2048 + ch * 16) = v; }
    asm volatile("s_waitcnt lgkmcnt(0)" ::: "memory"); __syncthreads();
#undef SLOAD
#undef KNORM
#undef SWRITE
}
#undef KSWZ
#undef SBAR
}
__device__ __forceinline__ void attn_flash_phase(Frame& F) {
    const int NU = BATCH * NKVH * (SEQ / 128) * 2;
    for (int c = F.vcu; c < NU / 8; c += F.G)
        for (int u = 8 * c; u < 8 * c + 8; ++u) {
            const int hp = u & 1, qb = (u >> 1) & 15, kvh = (u >> 5) & 3, b = u >> 7;
            att::attn_unit(F, b, kvh, qb, hp);
        }
}

constexpr size_t WS_T8D = WS_DOWNB, WS_T8U = WS_DOWNB + 32 * MiB, WS_SCD = 142 * MiB, WS_SCU = 142 * MiB + 65536;
__device__ __forceinline__ int pack_i8x4(float a, float b, float c, float d) {
    const int ia = (int)__builtin_rintf(a), ib = (int)__builtin_rintf(b), ic = (int)__builtin_rintf(c), id = (int)__builtin_rintf(d);
    return (ia & 0xff) | ((ib & 0xff) << 8) | ((ic & 0xff) << 16) | (id << 24);
}
__device__ __forceinline__ void peer_tables_phase(Frame& F) {
    const int gw = F.vcu * NWAVES + F.wave, NGW = F.G * NWAVES, lane = F.lane;
    const f32x4* G4 = (const f32x4*)F.in[IN_FFNG];
    for (int r = gw; r < 2 * NEXP; r += NGW) {
        const int tbl = r >= NEXP, e = r - tbl * NEXP;
        const f32x4* srcp = (const f32x4*)(F.in[tbl ? IN_PUP : IN_PDOWN]) + (size_t)e * 512;
        f32x4 v[8]; float amax = 0.f;
#pragma unroll
        for (int jj = 0; jj < 8; ++jj) { v[jj] = __builtin_nontemporal_load(srcp + lane + 64 * jj); if (!tbl) v[jj] = v[jj] * G4[lane + 64 * jj];
            amax = fmaxf(amax, fmaxf(fmaxf(fabsf(v[jj].x), fabsf(v[jj].y)), fmaxf(fabsf(v[jj].z), fabsf(v[jj].w)))); }
        amax = wave_max(amax);
        const float qmax = 127.f;
        const float inv = amax > 0.f ? qmax / amax : 0.f;
        if (lane == 0) ((float*)(F.ws + (tbl ? WS_SCU : WS_SCD)))[e] = amax / qmax;
        unsigned char* T8 = F.ws + (tbl ? WS_T8U : WS_T8D);
#pragma unroll
        for (int jj = 0; jj < 8; ++jj) { int q = 0;
            q = pack_i8x4(v[jj].x * inv, v[jj].y * inv, v[jj].z * inv, v[jj].w * inv);
            const int col = 256 * jj + 4 * lane;
            *(unsigned*)(T8 + ((size_t)(col >> 7) * NEXP + e) * 128 + (col & 127)) = (unsigned)q; }
    }
}

namespace pks {
using bf16x8 = __attribute__((ext_vector_type(8))) short;
using f32x16 = __attribute__((ext_vector_type(16))) float;
#define KSWZ(row, colB) ((row) * 256 + ((colB) ^ (((row) & 7) << 4)))
__device__ __forceinline__ int f2ord(float f) { const int s = __float_as_int(f); return s ^ ((s >> 31) & 0x7fffffff); }
__device__ __forceinline__ float ord2f(int s) { return __int_as_float(s ^ ((s >> 31) & 0x7fffffff)); }
__device__ __forceinline__ int imax(int a, int b) { return a > b ? a : b; }
__device__ __forceinline__ int imin(int a, int b) { return a < b ? a : b; }
__device__ __forceinline__ void merge16(int (&a)[16]) {
#pragma unroll
    for (int j = 8; j > 0; j >>= 1)
#pragma unroll
        for (int i = 0; i < 16; ++i) { const int l = i ^ j; if (l > i) { const int hi_ = imax(a[i], a[l]), lo_ = imin(a[i], a[l]); a[i] = hi_; a[l] = lo_; } }
}
__device__ __forceinline__ void sort16(int (&a)[16]) {
#pragma unroll
    for (int k = 2; k <= 16; k <<= 1)
#pragma unroll
        for (int j = k >> 1; j > 0; j >>= 1)
#pragma unroll
            for (int i = 0; i < 16; ++i) { const int l = i ^ j; if (l > i) { const int hi_ = imax(a[i], a[l]), lo_ = imin(a[i], a[l]); if ((i & k) == 0) { a[i] = hi_; a[l] = lo_; } else { a[i] = lo_; a[l] = hi_; } } }
}
__device__ __forceinline__ void top16(int (&a)[16], const int (&b)[16]) {
#pragma unroll
    for (int i = 0; i < 16; ++i) a[i] = imax(a[i], b[15 - i]);
    merge16(a);
}
__device__ __forceinline__ int crow(int r, int hi) { return (r & 3) + 8 * (r >> 2) + 4 * hi; }
__device__ __forceinline__ void stage_keys(Frame& F, int hd) {
    LAS char* lds = (LAS char*)F.lds;
#pragma unroll
    for (int i = 0; i < 8; ++i) { const int pc = F.tid + 512 * i, half = pc >> 11, row = (pc >> 4) & 127, ch = pc & 15;
        const float* src = F.in[half ? IN_SK2 : IN_SK1] + ((size_t)hd * 128 + row) * 128 + ch * 8;
        const f32x4 a = *(const f32x4*)src, b = *(const f32x4*)(src + 4);
        v4u w; w.x = pk2(a.x, a.y); w.y = pk2(a.z, a.w); w.z = pk2(b.x, b.y); w.w = pk2(b.z, b.w);
        *(LAS v4u*)(lds + half * 32768 + KSWZ(row, ch * 16)) = w; }
    LDS_WAIT(); __syncthreads();
}
__device__ __forceinline__ void unit(Frame& F, int tile, int hd) {
    const int tid = F.tid, wid = F.wave, lane = F.lane, r32 = lane & 31, hi = lane >> 5;
    LAS char* lds = (LAS char*)F.lds; LAS int* SCR = (LAS int*)(lds + 65536);
    const bf16* QP = (const bf16*)(F.ws + WS_BUFA); const float* SSQ = (const float*)(F.ws + WS_SSQ);
    int* IDX = (int*)(F.ws + WS_IDX); float* GATE = (float*)(F.ws + WS_GATE);
    const int t = tile * 256 + wid * 32 + r32;
    float rs2;
    { const f32x4* sp = (const f32x4*)(SSQ + (size_t)t * 32); float s = 0.f;
#pragma unroll
      for (int i = 0; i < 8; ++i) { const f32x4 v = sp[i]; s += (v.x + v.y) + (v.z + v.w); }
      rs2 = 1.0f / sqrtf(s * (1.f / D_MODEL) + RMS_EPS); }
    int T[2][16];
#pragma unroll
    for (int half = 0; half < 2; ++half) {
        bf16x8 qf[8];
        { const bf16* qp = QP + (size_t)t * 2048 + hd * 256 + half * 128 + hi * 8;
#pragma unroll
          for (int d0 = 0; d0 < 8; ++d0) qf[d0] = *(const bf16x8*)(qp + d0 * 16); }
        f32x16 p[4] = {};
        LAS const char* Ks = lds + half * 32768;
#pragma unroll
        for (int d0 = 0; d0 < 8; ++d0) { const int cb = (d0 * 16 + hi * 8) * 2;
#pragma unroll
            for (int kt = 0; kt < 4; ++kt) { const bf16x8 kf = *(LAS const bf16x8*)(Ks + KSWZ(32 * kt + r32, cb)); p[kt] = __builtin_amdgcn_mfma_f32_32x32x16_bf16(kf, qf[d0], p[kt], 0, 0, 0); } }
        int g[4][16];
#pragma unroll
        for (int kt = 0; kt < 4; ++kt)
#pragma unroll
            for (int r = 0; r < 16; ++r) g[kt][r] = (f2ord(p[kt][r]) & ~127) | (127 - (32 * kt + crow(r, hi)));
        sort16(g[0]); sort16(g[1]); sort16(g[2]); sort16(g[3]);
        top16(g[0], g[1]); top16(g[2], g[3]); top16(g[0], g[2]);
        int pr[16];
#pragma unroll
        for (int i = 0; i < 16; ++i) pr[i] = __shfl_xor(g[0][i], 32);
        top16(g[0], pr);
#pragma unroll
        for (int i = 0; i < 16; ++i) { T[half][i] = g[0][i]; SCR[(16 * half + i) * 512 + tid] = 127 - (g[0][i] & 127); }
    }
    float v1[16], v2[16];
#pragma unroll
    for (int i = 0; i < 16; ++i) { v1[i] = ord2f(T[0][i] & ~127); v2[i] = ord2f(T[1][i] & ~127); }
#define CAND(i, j) ((f2ord(v1[i] + v2[j]) & ~255) | (255 - (16 * (i) + (j))))
    const int NEGK = (int)0x80000000;
    int G0[16], G1[16], G2[16], G3[16];
#pragma unroll
    for (int j = 0; j < 16; ++j) G0[j] = CAND(0, j);
#pragma unroll
    for (int j = 0; j < 8; ++j) { G1[j] = CAND(1, j); G1[15 - j] = CAND(8 + j, 0); }
    G2[0] = CAND(2, 0); G2[1] = CAND(2, 1); G2[2] = CAND(2, 2); G2[3] = CAND(2, 3); G2[4] = CAND(2, 4);
    G2[5] = CAND(3, 0); G2[6] = CAND(3, 1); G2[7] = CAND(3, 2); G2[8] = CAND(3, 3);
    G2[9] = CAND(4, 0); G2[10] = CAND(4, 1); G2[11] = CAND(4, 2);
    G2[12] = CAND(5, 0); G2[13] = CAND(5, 1); G2[14] = CAND(6, 0); G2[15] = CAND(6, 1);
    G3[0] = CAND(7, 0); G3[1] = CAND(7, 1);
#pragma unroll
    for (int j = 2; j < 16; ++j) G3[j] = NEGK;
#undef CAND
    merge16(G1); sort16(G2);
    top16(G0, G1); top16(G2, G3); top16(G0, G2);
    float e[16], den = 0.f; const float vmax = ord2f(G0[0] & ~255);
#pragma unroll
    for (int r = 0; r < 16; ++r) { e[r] = __expf(rs2 * (ord2f(G0[r] & ~255) - vmax)); den += e[r]; }
    const float inv = 1.0f / den;
    LDS_WAIT(); asm volatile("" ::: "memory");
    int oi[8]; float og[8];
#pragma unroll
    for (int rr = 0; rr < 8; ++rr) { const int key = hi ? G0[8 + rr] : G0[rr]; const int code = 255 - (key & 255);
        oi[rr] = SCR[(code >> 4) * 512 + tid] * NKEYS + SCR[(16 + (code & 15)) * 512 + tid]; og[rr] = (hi ? e[8 + rr] : e[rr]) * inv; }
    int* ip = IDX + (size_t)t * KSEL + hd * 16 + hi * 8; float* gp = GATE + (size_t)t * KSEL + hd * 16 + hi * 8;
    *(v4u*)ip = v4u{(unsigned)oi[0], (unsigned)oi[1], (unsigned)oi[2], (unsigned)oi[3]}; *(v4u*)(ip + 4) = v4u{(unsigned)oi[4], (unsigned)oi[5], (unsigned)oi[6], (unsigned)oi[7]};
    *(f32x4*)gp = f32x4{og[0], og[1], og[2], og[3]}; *(f32x4*)(gp + 4) = f32x4{og[4], og[5], og[6], og[7]};
    LDS_WAIT(); asm volatile("" ::: "memory");
}
#undef KSWZ
}
__device__ __forceinline__ void peer_score_mfma_phase(Frame& F) {
    int staged = -1;
    for (int u = F.vcu; u < (T_TOK / 256) * PEER_H; u += F.G) {
        const int hd = u & 7, tile = u >> 3;
        if (hd != staged) { __syncthreads(); pks::stage_keys(F, hd); staged = hd; }
        pks::unit(F, tile, hd);
    }
    __syncthreads();
}

typedef __bf16 bf16x2v __attribute__((ext_vector_type(2)));
#define BF2(x) __builtin_bit_cast(bf16x2v, (unsigned)(x))
__device__ __forceinline__ float dot8_bf(v4u a, v4u b) {
    float d = __builtin_amdgcn_fdot2_f32_bf16(BF2(a.x), BF2(b.x), 0.f, false);
    d = __builtin_amdgcn_fdot2_f32_bf16(BF2(a.y), BF2(b.y), d, false);
    d = __builtin_amdgcn_fdot2_f32_bf16(BF2(a.z), BF2(b.z), d, false);
    return __builtin_amdgcn_fdot2_f32_bf16(BF2(a.w), BF2(b.w), d, false);
}
__device__ __forceinline__ float dpp_sum8(float d) {
    d += __builtin_bit_cast(float, __builtin_amdgcn_update_dpp(0, __builtin_bit_cast(int, d), 0xB1, 0xF, 0xF, true));
    d += __builtin_bit_cast(float, __builtin_amdgcn_update_dpp(0, __builtin_bit_cast(int, d), 0x4E, 0xF, 0xF, true));
    d += __builtin_bit_cast(float, __builtin_amdgcn_update_dpp(0, __builtin_bit_cast(int, d), 0x141, 0xF, 0xF, true));
    return d;
}
#ifndef MK_XMODE
#define MK_XMODE 1
#endif
#ifndef GATHER_AUX
#define GATHER_AUX 16
#endif
#ifndef MK_ALIGN_EVERY
#define MK_ALIGN_EVERY 16
#endif
#define DPPF(x, ctrl) __builtin_bit_cast(float, __builtin_amdgcn_update_dpp(0, __builtin_bit_cast(int, (float)(x)), ctrl, 0xF, 0xF, true))
constexpr size_t WS_X8 = WS_Q;
#define DPPI(x, ctrl) __builtin_amdgcn_update_dpp(0, (int)(x), ctrl, 0xF, 0xF, true)
__device__ __forceinline__ void peer_expert_sliced_phase(Frame& F, const XcdBarrier& bar, const bool dostore) {
    const int xmode = dostore ? 1 : MK_XMODE;
    const int lane = F.lane, j = lane >> 3, sub = lane & 7;
    LAS unsigned* IDXL = (LAS unsigned*)(F.lds + F.wave * 16384); LAS float* ACTL = (LAS float*)(F.lds + F.wave * 16384 + 8192); LAS int* ACTI = (LAS int*)ACTL;
    LAS float* XSC = (LAS float*)(F.lds + 131072 + F.wave * 64); LAS float* WSC = (LAS float*)(F.lds + 131072 + 512 + F.wave * 64); LAS signed char* W8L = (LAS signed char*)(F.lds + 131072 + 1024 + F.wave * 2048);
    const bf16* XB = (const bf16*)(F.ws + WS_BUFB); const float* SSQ = (const float*)(F.ws + WS_SSQ);
    const int* IDX = (const int*)(F.ws + WS_IDX); const float* GATE = (const float*)(F.ws + WS_GATE);
    const unsigned char* DBb = F.ws + WS_T8D; const unsigned char* UBb = F.ws + WS_T8U; unsigned char* X8 = F.ws + WS_X8;
    const __amdgpu_buffer_rsrc_t rsD = __builtin_amdgcn_make_buffer_rsrc((void*)DBb, 0, 32 << 20, 0x00020000), rsU = __builtin_amdgcn_make_buffer_rsrc((void*)UBb, 0, 32 << 20, 0x00020000);
    const __amdgpu_buffer_rsrc_t rsX = __builtin_amdgcn_make_buffer_rsrc((void*)X8, 0, 64 << 20, 0x00020000);
    const float* SCD = (const float*)(F.ws + WS_SCD); const float* SCU = (const float*)(F.ws + WS_SCU);
    struct DBuf { v4u pc[16]; v4u x; };
    struct UBuf { v4u pc[16]; };
    constexpr int NIT = 16 * 16;
    for (int chunk = F.vcu; chunk < T_TOK / 128; chunk += F.G) {
        const int t0 = chunk * 128 + F.wave * 16;
        for (int tok = 0; tok < 16; ++tok) {
#pragma unroll
            for (int a = 0; a < 2; ++a) { IDXL[tok * 128 + 64 * a + lane] = (unsigned)(xmode == 2 ? (IDX[(size_t)(t0 + tok) * KSEL + 64 * a + lane] & 63) : IDX[(size_t)(t0 + tok) * KSEL + 64 * a + lane]) * 128u; ACTI[tok * 128 + 64 * a + lane] = 0; }
            const v4u* xr = (const v4u*)(XB + (size_t)(t0 + tok) * 2048 + 32 * lane); v4u w[4]; float amax = 0.f;
#pragma unroll
            for (int k = 0; k < 4; ++k) { w[k] = xr[k];
#pragma unroll
                for (int c = 0; c < 4; ++c) amax = fmaxf(amax, fmaxf(fabsf(bflo(w[k][c])), fabsf(bfhi(w[k][c])))); }
            amax = wave_max(amax); const float inv = amax > 0.f ? 127.f / amax : 0.f;
            if (lane == 0) XSC[tok] = amax * (1.f / 127.f);
            unsigned q8[8];
#pragma unroll
            for (int d = 0; d < 8; ++d) { const unsigned wa = w[d >> 1][2 * (d & 1)], wb = w[d >> 1][2 * (d & 1) + 1]; q8[d] = (unsigned)pack_i8x4(bflo(wa) * inv, bfhi(wa) * inv, bflo(wb) * inv, bfhi(wb) * inv); }
            unsigned char* xo = X8 + (size_t)(t0 + tok) * 2048 + 32 * lane;
            *(v4u*)xo = v4u{q8[0], q8[1], q8[2], q8[3]}; *(v4u*)(xo + 16) = v4u{q8[4], q8[5], q8[6], q8[7]};
        }
        asm volatile("s_waitcnt vmcnt(0) lgkmcnt(0)" ::: "memory");
        auto dload = [&](DBuf& g, int it) { const int sg = it >> 4, tok = it & 15;
            g.x = __builtin_bit_cast(v4u, __builtin_amdgcn_raw_buffer_load_b128(rsX, (unsigned)((t0 + tok) * 2048 + 128 * sg + 16 * sub), 0, GATHER_AUX));
            const unsigned base = (unsigned)sg * (NEXP * 128) + sub * 16;
#pragma unroll
            for (int a = 0; a < 2; ++a)
#pragma unroll
                for (int i = 0; i < 8; ++i) g.pc[8 * a + i] = __builtin_bit_cast(v4u, __builtin_amdgcn_raw_buffer_load_b128(rsD, base + IDXL[tok * 128 + 64 * a + 8 * j + i], 0, GATHER_AUX)); };
        auto dcomp = [&](DBuf& g, int it) { const int tok = it & 15;
#pragma unroll
            for (int a = 0; a < 2; ++a) { int r[8];
#pragma unroll
                for (int i = 0; i < 8; ++i) { const v4u pc = g.pc[8 * a + i];
                    int acc = __builtin_amdgcn_sdot4((int)pc.x, (int)g.x.x, 0, false); acc = __builtin_amdgcn_sdot4((int)pc.y, (int)g.x.y, acc, false);
                    acc = __builtin_amdgcn_sdot4((int)pc.z, (int)g.x.z, acc, false); r[i] = __builtin_amdgcn_sdot4((int)pc.w, (int)g.x.w, acc, false); }
                int s4[4], s2[2];
#pragma unroll
                for (int i = 0; i < 4; ++i) { const bool up = sub >= 4; const int send = up ? r[i] : r[i + 4], keep = up ? r[i + 4] : r[i]; s4[i] = keep + DPPI(send, 0x141); }
#pragma unroll
                for (int i = 0; i < 2; ++i) { const bool up = (sub & 2) != 0; const int send = up ? s4[i] : s4[i + 2], keep = up ? s4[i + 2] : s4[i]; s2[i] = keep + DPPI(send, 0x4E); }
                { const bool up = (sub & 1) != 0; const int send = up ? s2[0] : s2[1], keep = up ? s2[1] : s2[0]; ACTI[tok * 128 + 64 * a + lane] += keep + DPPI(send, 0xB1); } } };
        { DBuf A, B; dload(A, 0);
          if (xmode != 3) for (int it = 0; it < NIT; it += 2) { if ((it & (16 * MK_ALIGN_EVERY - 1)) == 0) xcd_align(bar); dload(B, it + 1); dcomp(A, it); if (it + 2 < NIT) dload(A, it + 2); dcomp(B, it + 1); } }
        LDS_WAIT(); asm volatile("" ::: "memory");
        for (int tok = 0; tok < 16; ++tok) {
            const float rs2 = XSC[tok] / sqrtf(wave_sum(lane < 32 ? SSQ[(size_t)(t0 + tok) * 32 + lane] : 0.f) * (1.f / D_MODEL) + RMS_EPS);
            float wv[2];
#pragma unroll
            for (int a = 0; a < 2; ++a) { const int p = tok * 128 + 64 * a + lane; const unsigned e = IDXL[p] >> 7;
                wv[a] = GATE[(size_t)(t0 + tok) * KSEL + 64 * a + lane] * gelu_erf((float)ACTI[p] * rs2 * SCD[e]) * SCU[e]; }
            const float wmax = wave_max(fmaxf(fabsf(wv[0]), fabsf(wv[1]))), winv = wmax > 0.f ? 127.f / wmax : 0.f;
            if (lane == 0) WSC[tok] = wmax * (1.f / 127.f);
#pragma unroll
            for (int a = 0; a < 2; ++a) W8L[tok * 128 + 64 * a + lane] = (signed char)(int)__builtin_rintf(wv[a] * winv);
        }
        LDS_WAIT(); asm volatile("" ::: "memory");
        auto uload = [&](UBuf& g, int it) { const int sg = it >> 4, tok = it & 15;
            const unsigned base = (unsigned)sg * (NEXP * 128) + sub * 16;
#pragma unroll
            for (int a = 0; a < 2; ++a)
#pragma unroll
                for (int i = 0; i < 8; ++i) g.pc[8 * a + i] = __builtin_bit_cast(v4u, __builtin_amdgcn_raw_buffer_load_b128(rsU, base + IDXL[tok * 128 + 64 * a + 8 * j + i], 0, GATHER_AUX)); };
        auto ucomp = [&](UBuf& g, int it) { const int sg = it >> 4, tok = it & 15;
            float* op = F.out + (size_t)(t0 + tok) * 2048 + 128 * sg + 16 * sub + 2 * j; const unsigned xw_ = *(const unsigned*)(XB + (size_t)(t0 + tok) * 2048 + 128 * sg + 16 * sub + 2 * j); const f32x2_t x1 = {bflo(xw_), bfhi(xw_)};
            int acc[16];
#pragma unroll
            for (int c = 0; c < 16; ++c) acc[c] = 0;
#pragma unroll
            for (int a = 0; a < 2; ++a) { const v2u wq = *(const LAS v2u*)(W8L + tok * 128 + 64 * a + 8 * j);
#pragma unroll
                for (int h = 0; h < 2; ++h) { const int wd = (int)wq[h];
#pragma unroll
                    for (int d = 0; d < 4; ++d) { const unsigned A_ = g.pc[8 * a + 4 * h][d], B_ = g.pc[8 * a + 4 * h + 1][d], C_ = g.pc[8 * a + 4 * h + 2][d], D_ = g.pc[8 * a + 4 * h + 3][d];
                        const unsigned t0_ = __builtin_amdgcn_perm(B_, A_, 0x05010400u), t1_ = __builtin_amdgcn_perm(B_, A_, 0x07030602u), u0_ = __builtin_amdgcn_perm(D_, C_, 0x05010400u), u1_ = __builtin_amdgcn_perm(D_, C_, 0x07030602u);
                        acc[4 * d + 0] = __builtin_amdgcn_sdot4((int)__builtin_amdgcn_perm(u0_, t0_, 0x05040100u), wd, acc[4 * d + 0], false);
                        acc[4 * d + 1] = __builtin_amdgcn_sdot4((int)__builtin_amdgcn_perm(u0_, t0_, 0x07060302u), wd, acc[4 * d + 1], false);
                        acc[4 * d + 2] = __builtin_amdgcn_sdot4((int)__builtin_amdgcn_perm(u1_, t1_, 0x05040100u), wd, acc[4 * d + 2], false);
                        acc[4 * d + 3] = __builtin_amdgcn_sdot4((int)__builtin_amdgcn_perm(u1_, t1_, 0x07060302u), wd, acc[4 * d + 3], false); } } }
            int q4[8], q2[4], q1[2];
#define SWAPSUMI(fn, lo_, hi_) ({ auto r_ = fn((unsigned)(lo_), (unsigned)(hi_), false, false); const unsigned r0_ = r_[0], r1_ = r_[1]; (int)(r0_ + r1_); })
#pragma unroll
            for (int c = 0; c < 8; ++c) q4[c] = SWAPSUMI(__builtin_amdgcn_permlane32_swap, acc[c], acc[c + 8]);
#pragma unroll
            for (int c = 0; c < 4; ++c) q2[c] = SWAPSUMI(__builtin_amdgcn_permlane16_swap, q4[c], q4[c + 4]);
#pragma unroll
            for (int c = 0; c < 2; ++c) { const bool hi = (lane & 8) != 0; const int send = hi ? q2[c] : q2[c + 2], keep = hi ? q2[c + 2] : q2[c]; q1[c] = keep + DPPI(send, 0x128); }
            const float wsc = WSC[tok];
            const f32x2_t val = {x1.x + (float)q1[0] * wsc, x1.y + (float)q1[1] * wsc};
            if (dostore) __builtin_nontemporal_store(val, (f32x2_t*)op); else asm volatile("" :: "v"(val.x), "v"(val.y), "v"(op)); };
        { UBuf A, B; uload(A, 0);
          if (xmode != 4) for (int it = 0; it < NIT; it += 2) { if ((it & (16 * MK_ALIGN_EVERY - 1)) == 0) xcd_align(bar); uload(B, it + 1); ucomp(A, it); if (it + 2 < NIT) uload(A, it + 2); ucomp(B, it + 1); } }
    }
}

constexpr int N_PHASES = 11;
struct Args { const float* in[24]; float* out; unsigned char* ws; int ph_lo, ph_hi, li, pad; };
__global__ void __launch_bounds__(NWAVES * 64, 2) mk_fwd(Args args) {
    extern __shared__ __attribute__((aligned(16))) unsigned char lds[];
    Frame F;
    F.lds = (LAS unsigned char*)lds;
    F.MISC = (volatile LAS unsigned*)(F.lds + MISC_OFF);
    F.tid = threadIdx.x; F.lane = F.tid & 63; F.wave = __builtin_amdgcn_readfirstlane(F.tid >> 6);
    F.G = gridDim.x; { const int bx = blockIdx.x; F.vcu = (F.G % 8 == 0) ? (bx % 8) * (F.G / 8) + bx / 8 : bx; }
    F.ws = args.ws; F.out = args.out; F.ctl = (gu32*)(args.ws + WS_CTL);
    F.in = args.in;
    for (int u = F.tid; u < (LDS_BYTES - LDSCTL_OFF) / 4; u += NWAVES * 64) ((LAS unsigned*)(F.lds + LDSCTL_OFF))[u] = 0u;
    __syncthreads();
    const int lo = args.ph_lo, hi = args.ph_hi;
    XcdBarrier bar; bar.bar = (unsigned*)(F.ctl + CW_BAR); bar.x = 0; bar.st = nullptr;
    if (hi - lo > 1) bar = xcd_barrier_post((unsigned*)(F.ctl + CW_BAR), F.MISC + 8);
#define IN(k) (lo <= (k) && (k) < hi)
#define BOTH(k) (IN(k) && IN((k) + 1))
#define GRID_BAR() xcd_barrier(bar)
#ifndef MK_PROBE_PHASE
#define MK_PROBE_PHASE -1
#endif
#ifndef MK_PROBE_REPS
#define MK_PROBE_REPS 1
#endif
#define REP(k) for (int rp_ = 0; rp_ < ((k) == MK_PROBE_PHASE ? 1 + MK_PROBE_REPS : 1); ++rp_)
    unsigned char* ws = args.ws;
    bf16* BUFA = (bf16*)(ws + WS_BUFA); bf16* BUFB = (bf16*)(ws + WS_BUFB);

    if (IN(0)) { REP(0) { for (int wi = F.vcu; wi < SSM_G * 4; wi += F.G) ssm::precompute_group(F, wi >> 2, wi & 3); p0_prologue(F); }
        if (MK_PROBE_PHASE == 20) for (int wi = F.vcu; wi < SSM_G * 4; wi += F.G) ssm::precompute_group(F, wi >> 2, wi & 3);
        if (MK_PROBE_PHASE == 21) p0_prologue(F, 1);
        if (MK_PROBE_PHASE == 22) p0_prologue(F, 2);
        if (BOTH(0)) GRID_BAR(); }
    if (IN(1)) {
        w8_convert_phase(F);
        GRID_BAR();
        pg8::Gemm g8{(const bf16*)(ws + WS_H8), (const bf16*)(ws + WS_W8), T_TOK, IN_W, D_MODEL / 2}; pg8::StaticOrder S8; S8.init(T_TOK, IN_W, F.G, (int)blockIdx.x);
        pg8::EpiProj8 E8{ws, WS_Q, WS_KV, WS_U, WS_GT, WS_HS, WS_CTL + (size_t)CW_AMAX * 4};
        REP(1) pg8::gemm_phase<pg8::EpiProj8, pg8::StaticOrder, true, true, true>(F.lds + RING_OFF, g8, S8, E8);
        if (BOTH(1)) GRID_BAR();
    }
    if (IN(2)) { REP(2) ssm_mfma_phase(F); }

    if (IN(4)) { REP(4) attn_flash_phase(F); if (BOTH(4)) GRID_BAR(); }
    if (IN(5)) {
        pg8::Gemm g{(const bf16*)(ws + WS_BUFA), (const bf16*)(ws + WS_WAO8), T_TOK, D_MODEL, D_MODEL / 2}; pg8::StaticOrder S; S.init(T_TOK, D_MODEL, F.G, (int)blockIdx.x);
        pg8::EpiGateMul8 E{ws, WS_BUFB, WS_GT, WS_CTL + (size_t)CW_AMAX_AO * 4, 1.0f / (440.0f * O8_SCALE)};
        REP(5) pg8::gemm_phase<pg8::EpiGateMul8, pg8::StaticOrder, true, true, true>(F.lds + RING_OFF, g, S, E);
        if (BOTH(5)) GRID_BAR();
    }
    if (IN(6)) {
        pg8::Gemm g{(const bf16*)(ws + WS_YACT), (const bf16*)(ws + WS_WGLU8), T_TOK, 4096, SSM_W / 2, 1}; pg8::StaticOrder S; S.init(T_TOK, 4096, F.G, (int)blockIdx.x);
        pg8::EpiGlu8 E{ws, WS_BUFA, WS_BUFB, WS_GT + 2048 * 2, WS_CTL + (size_t)CW_AMAX_GLU * 4, 1.0f / (440.0f * Y8_SCALE), M8_SCALE};
        REP(6) pg8::gemm_phase<pg8::EpiGlu8, pg8::StaticOrder, true, true, true>(F.lds + RING_OFF, g, S, E);
        if (BOTH(6)) GRID_BAR();
    }
    if (IN(7)) {
        REP(11) peer_tables_phase(F);
        pg8::Gemm g{BUFA, (const bf16*)(ws + WS_WOUT8), T_TOK, D_MODEL, D_MODEL / 2}; pg8::StaticOrder S; S.init(T_TOK, D_MODEL, F.G, (int)blockIdx.x);
        pg8::EpiResid8 E{ws, F.in[IN_X], WS_BUFB, WS_SSQ, WS_CTL + (size_t)CW_AMAX_OUT * 4, 1.0f / (440.0f * M8_SCALE)};
        REP(7) pg8::gemm_phase<pg8::EpiResid8, pg8::StaticOrder, true, true, true>(F.lds + RING_OFF, g, S, E);
        if (BOTH(7)) GRID_BAR();
    }
    if (IN(8)) {
        pg8::Gemm g{BUFB, (const bf16*)(ws + WS_WPQ), T_TOK, D_MODEL, D_MODEL}; pg8::StaticOrder S; S.init(T_TOK, D_MODEL, F.G, (int)blockIdx.x);
        pg8::EpiPlain E{BUFA, D_MODEL};
        REP(8) pg8::gemm_phase<pg8::EpiPlain, pg8::StaticOrder, true, true>(F.lds + RING_OFF, g, S, E);
        if (BOTH(8)) GRID_BAR();
    }
    if (IN(9)) { REP(9) peer_score_mfma_phase(F); if (BOTH(9)) GRID_BAR(); }
    if (IN(10)) { for (int rp_ = 0; rp_ < (10 == MK_PROBE_PHASE ? MK_PROBE_REPS : 0); ++rp_) peer_expert_sliced_phase(F, bar, false); peer_expert_sliced_phase(F, bar, true); }
#undef IN
#undef BOTH
}

#ifndef MK_ONE_LAUNCH
#define MK_ONE_LAUNCH 1
#endif
extern "C" void kernel_launch(void* const* d_in, const int* in_sizes, int n_in, void* d_out, int out_size, void* d_ws, size_t ws_size, hipStream_t stream) {
    static int grid = 0;
    if (grid == 0) {
        if (n_in != 24 || in_sizes[0] != T_TOK * D_MODEL || out_size != T_TOK * D_MODEL || ws_size < WS_END) {
            fprintf(stderr, "kernel_launch: shape mismatch: n_in %d in0 %d out %d ws %zu (need >= %zu)\n", n_in, n_in > 0 ? in_sizes[0] : -1, out_size, ws_size, (size_t)WS_END); grid = -1; return; }
        int dev = 0, cus = 0, per_cu = 0;
        if (hipGetDevice(&dev) != hipSuccess || hipDeviceGetAttribute(&cus, hipDeviceAttributeMultiprocessorCount, dev) != hipSuccess) { fprintf(stderr, "kernel_launch: device query failed\n"); grid = -1; return; }
        if (hipFuncSetAttribute((const void*)mk_fwd, hipFuncAttributeMaxDynamicSharedMemorySize, LDS_BYTES) != hipSuccess) { fprintf(stderr, "kernel_launch: hipFuncSetAttribute failed\n"); grid = -1; return; }
        if (hipOccupancyMaxActiveBlocksPerMultiprocessor(&per_cu, (const void*)mk_fwd, NWAVES * 64, LDS_BYTES) != hipSuccess || per_cu < 1)
            fprintf(stderr, "kernel_launch: note: occupancy query reports %d workgroups per CU\n", per_cu);
        (void)hipGetLastError();
        grid = cus;
    }
    if (grid < 0) return;
    if (hipMemsetAsync((char*)d_ws + WS_CTL, 0, CTL_ZERO_BYTES, stream) != hipSuccess) { fprintf(stderr, "kernel_launch: memset failed\n"); return; }
    Args a{};
    for (int i = 0; i < 24; ++i) a.in[i] = (const float*)d_in[i];
    a.out = (float*)d_out; a.ws = (unsigned char*)d_ws;
#if MK_ONE_LAUNCH
    a.ph_lo = 0; a.ph_hi = N_PHASES; a.li = 0;
    void* kargs[] = {&a};
    hipError_t le = hipLaunchCooperativeKernel((const void*)mk_fwd, dim3(grid), dim3(NWAVES * 64), kargs, LDS_BYTES, stream);
    if (le != hipSuccess) fprintf(stderr, "kernel_launch: cooperative launch failed: %s\n", hipGetErrorName(le));
#else
    for (int li = 0; li < N_PHASES; ++li) {
        a.ph_lo = li; a.ph_hi = li + 1; a.li = li;
        hipLaunchKernelGGL(mk_fwd, dim3(grid), dim3(NWAVES * 64), LDS_BYTES, stream, a);
        const hipError_t le = hipPeekAtLastError();
        if (le != hipSuccess) { fprintf(stderr, "kernel_launch: launch %d failed: %s\n", li, hipGetErrorName(le)); break; }
    }
#endif
}
```

```cpp
#include <hip/hip_runtime.h>
#include <cstdio>
#include <cstdint>
#include <cmath>

constexpr int D_MODEL = 2048, BATCH = 16, SEQ = 2048, T_TOK = BATCH * SEQ;
constexpr int NQH = 16, NKVH = 4, HD = 128, WINDOW = 128;
constexpr int SSM_W = 1024, SSM_G = 64, SSM_N = 64, SSM_C = 16;
constexpr int PEER_H = 8, NKEYS = 128, NEXP = NKEYS * NKEYS, PEER_HALF = 128, PEER_TOPK = 16, KSEL = PEER_H * PEER_TOPK;
constexpr int IN_W = 8192;
constexpr float RMS_EPS = 1e-6f;

#define GAS __attribute__((address_space(1)))
#define LAS __attribute__((address_space(3)))
typedef unsigned short bf16;
typedef unsigned v4u __attribute__((ext_vector_type(4)));
typedef unsigned v2u __attribute__((ext_vector_type(2)));
typedef float f32x4 __attribute__((ext_vector_type(4)));
typedef float f32x2_t __attribute__((ext_vector_type(2)));
typedef __bf16 bf16x2_t __attribute__((ext_vector_type(2)));
#define LDS_WAIT() asm volatile("s_waitcnt lgkmcnt(0)" ::: "memory")
#define VM_WAIT() asm volatile("s_waitcnt vmcnt(0)" ::: "memory")
#define RLX_AGENT __ATOMIC_RELAXED, __HIP_MEMORY_SCOPE_AGENT
typedef GAS unsigned gu32;

__device__ __forceinline__ unsigned pk2(float lo, float hi) { f32x2_t v = {lo, hi}; bf16x2_t b = __builtin_convertvector(v, bf16x2_t); return __builtin_bit_cast(unsigned, b); }
__device__ __forceinline__ float bflo(unsigned w) { return __uint_as_float(w << 16); }
__device__ __forceinline__ float bfhi(unsigned w) { return __uint_as_float(w & 0xffff0000u); }
__device__ __forceinline__ float wave_sum(float v) {
#pragma unroll
    for (int o = 1; o < 64; o <<= 1) v += __shfl_xor(v, o);
    return v;
}
__device__ __forceinline__ float wave_max(float v) {
#pragma unroll
    for (int o = 1; o < 64; o <<= 1) v = fmaxf(v, __shfl_xor(v, o));
    return v;
}
__device__ __forceinline__ float sigmoidf_(float x) { return __builtin_amdgcn_rcpf(1.f + __expf(-x)); }
__device__ __forceinline__ float gelu_erf(float x) { return 0.5f * x * (1.f + erff(x * 0.70710678118654752f)); }

namespace pg8 {
#define PG8_LAS __attribute__((address_space(3)))
typedef unsigned short bf16_t;
typedef short bf16x8 __attribute__((ext_vector_type(8)));
typedef float f32x4 __attribute__((ext_vector_type(4)));
typedef unsigned u32x4 __attribute__((ext_vector_type(4)));
typedef int v4i_t __attribute__((ext_vector_type(4)));
typedef int v8i_t __attribute__((ext_vector_type(8)));
constexpr int BM = 256, BK = 64, HALF = 128, HTB = HALF * BK * 2  , STAGE_BYTES = 8 * HTB, NXCD = 8, WGM = 8;

__host__ __device__ __forceinline__ int lds_byte(int r, int c) { const int st = (r >> 4) * 2 + (c >> 5), rr = r & 15, cc = c & 31, ob = rr * 64 + cc * 2; return st * 1024 + (ob ^ (((ob >> 9) & 1) << 5)); }
__host__ __device__ __forceinline__ void stage_rc(int b, int& R, int& C) { const int st = b / 1024, sb = b % 1024, swz = sb ^ (((sb >> 9) & 1) << 5); R = (st >> 1) * 16 + swz / 64; C = (st & 1) * 32 + (swz % 64) / 2; }
__host__ __device__ __forceinline__ int perm32(int rho) { const int n = rho >> 4, i = rho & 15; return 8 * (i >> 2) + 4 * n + (i & 3); }

struct Unit { int pm, pn; };
struct Gemm { const bf16_t* A; const bf16_t* Bt; int M, N, K; int amode; };

struct StaticOrder {
    int nM, nN, nwg, G, c;
    __host__ __device__ void init(int M, int N, int G_, int c_) { nM = M / BM; nN = N / BM; nwg = nM * nN; G = G_; c = c_; }
    __host__ __device__ bool next(int i, Unit& u) const {
        const long L = (long)i * G + c; if (L >= nwg) return false;
        int wgid = (int)L; { const int q = nwg / NXCD, r = nwg % NXCD, xcd = wgid % NXCD, off = wgid / NXCD; wgid = (xcd < r ? xcd * (q + 1) : r * (q + 1) + (xcd - r) * q) + off; }
        const int nig = WGM * nN, gid = wgid / nig, fm = gid * WGM, gsz = (nM - fm) < WGM ? (nM - fm) : WGM;
        u.pm = fm + ((wgid % nig) % gsz); u.pn = (wgid % nig) / gsz; return true;
    }
    __device__ __forceinline__ void a_ready(const Unit&) const {}
    __device__ __forceinline__ void done(const Unit&) const {}
};

__device__ __forceinline__ unsigned cvt_pk_bf16(float lo, float hi) { return ::pk2(lo, hi); }
__device__ __forceinline__ float sgm(float x) { return __builtin_amdgcn_rcpf(1.f + __expf(-x)); }

struct EpiProj {
    static constexpr bool PERM = true, AFTER_DRAIN = false;
    bf16_t* Q; bf16_t* KV; bf16_t* U; bf16_t* GT;
    __device__ __forceinline__ void operator()(const f32x4 (&acc)[2][2][4][2], const Unit& u, int wr, int wc, int fr, int fq) const {
        const int pn = u.pn; bf16_t* base; int ld, colt; bool sig = false;
        if (pn < 8) { base = Q; ld = 2048; colt = pn * 256; }
        else if (pn < 12) { base = KV; ld = 1024; colt = (pn - 8) * 256; }
        else if (pn < 16) { base = U; ld = 0; colt = (pn - 12) * 256; }
        else { base = GT; ld = 4096; colt = (pn - 16) * 256; sig = true; }
        const int row0 = u.pm * BM + wr * 64 + fr, col0 = colt + wc * 32 + 8 * fq;
#pragma unroll
        for (int ai = 0; ai < 2; ++ai)
#pragma unroll
            for (int m = 0; m < 4; ++m) { const int row = row0 + ai * HALF + m * 16; bf16_t* rowp = base + (size_t)row * ld + col0;
#pragma unroll
                for (int bj = 0; bj < 2; ++bj) { f32x4 v0 = acc[ai][bj][m][0], v1 = acc[ai][bj][m][1];
                    if (sig) {
#pragma unroll
                        for (int e = 0; e < 4; ++e) { v0[e] = sgm(v0[e]); v1[e] = sgm(v1[e]); } }
                    u32x4 w; w.x = cvt_pk_bf16(v0[0], v0[1]); w.y = cvt_pk_bf16(v0[2], v0[3]); w.z = cvt_pk_bf16(v1[0], v1[1]); w.w = cvt_pk_bf16(v1[2], v1[3]);
                    if (ld == 0) { const int col = col0 + bj * HALF; *(u32x4*)(base + (((size_t)(row >> 11) * 64 + (col >> 4)) * 2048 + (row & 2047)) * 16 + (col & 8)) = w; }
                    else *(u32x4*)(rowp + bj * HALF) = w; } }
    }
};
struct EpiProj8 {
    static constexpr bool PERM = true, AFTER_DRAIN = false;
    unsigned char* ws; size_t o_q, o_kv, o_u, o_gt, o_hs, o_amax;
    __device__ __forceinline__ void operator()(const f32x4 (&acc)[2][2][4][2], const Unit& u, int wr, int wc, int fr, int fq) const {
        asm volatile("s_nop 15\n\ts_nop 15" ::: "memory");
        const float* HS = (const float*)(ws + o_hs); const float* AMAX = (const float*)(ws + o_amax);
        const int pn = u.pn; bf16_t* base; int ld, colt; bool sig = false;
        if (pn < 8) { base = (bf16_t*)(ws + o_q); ld = 2048; colt = pn * 256; }
        else if (pn < 12) { base = (bf16_t*)(ws + o_kv); ld = 1024; colt = (pn - 8) * 256; }
        else if (pn < 16) { base = (bf16_t*)(ws + o_u); ld = 0; colt = (pn - 12) * 256; }
        else { base = (bf16_t*)(ws + o_gt); ld = 4096; colt = (pn - 16) * 256; sig = true; }
        const int row0 = u.pm * BM + wr * 64 + fr, col0 = colt + wc * 32 + 8 * fq, acol0 = pn * 256 + wc * 32 + 8 * fq;
        float hsv[2][4]; f32x4 cv[2][2];
#pragma unroll
        for (int ai = 0; ai < 2; ++ai)
#pragma unroll
            for (int m = 0; m < 4; ++m) hsv[ai][m] = HS[row0 + ai * HALF + m * 16];
#pragma unroll
        for (int bj = 0; bj < 2; ++bj) { cv[bj][0] = *(const f32x4*)(AMAX + acol0 + bj * HALF) * (1.0f / 440.0f); cv[bj][1] = *(const f32x4*)(AMAX + acol0 + bj * HALF + 4) * (1.0f / 440.0f); }
        __builtin_amdgcn_sched_barrier(0);
#pragma unroll
        for (int bj = 0; bj < 2; ++bj) {
            const f32x4 c0 = cv[bj][0], c1 = cv[bj][1];
#pragma unroll
            for (int ai = 0; ai < 2; ++ai)
#pragma unroll
                for (int m = 0; m < 4; ++m) { const int row = row0 + ai * HALF + m * 16; const float hs = hsv[ai][m];
                    f32x4 v0 = acc[ai][bj][m][0] * c0 * hs, v1 = acc[ai][bj][m][1] * c1 * hs;
                    if (sig) {
#pragma unroll
                        for (int e = 0; e < 4; ++e) { v0[e] = sgm(v0[e]); v1[e] = sgm(v1[e]); } }
                    u32x4 w; w.x = cvt_pk_bf16(v0[0], v0[1]); w.y = cvt_pk_bf16(v0[2], v0[3]); w.z = cvt_pk_bf16(v1[0], v1[1]); w.w = cvt_pk_bf16(v1[2], v1[3]);
                    const int col = col0 + bj * HALF;
                    if (ld == 0) *(u32x4*)(base + (((size_t)(row >> 11) * 64 + (col >> 4)) * 2048 + (row & 2047)) * 16 + (col & 8)) = w;
                    else *(u32x4*)(base + (size_t)row * ld + col) = w; }
        }
    }
};
struct EpiGateMul8 {
    static constexpr bool PERM = true, AFTER_DRAIN = false;
    unsigned char* ws; size_t o_out, o_gate, o_amax; float inv_scale;
    __device__ __forceinline__ void operator()(const f32x4 (&acc)[2][2][4][2], const Unit& u, int wr, int wc, int fr, int fq) const {
        asm volatile("s_nop 15\n\ts_nop 15" ::: "memory");
        bf16_t* O = (bf16_t*)(ws + o_out); const bf16_t* G = (const bf16_t*)(ws + o_gate); const float* AMAX = (const float*)(ws + o_amax);
        const int row0 = u.pm * BM + wr * 64 + fr, col0 = u.pn * BM + wc * 32 + 8 * fq;
        u32x4 gl[2][2][4];
#pragma unroll
        for (int bj = 0; bj < 2; ++bj)
#pragma unroll
            for (int ai = 0; ai < 2; ++ai)
#pragma unroll
                for (int m = 0; m < 4; ++m) gl[bj][ai][m] = *(const u32x4*)(G + (size_t)(row0 + ai * HALF + m * 16) * 4096 + col0 + bj * HALF);
        __builtin_amdgcn_sched_barrier(0);
#pragma unroll
        for (int bj = 0; bj < 2; ++bj) {
            const f32x4 c0 = *(const f32x4*)(AMAX + col0 + bj * HALF) * inv_scale, c1 = *(const f32x4*)(AMAX + col0 + bj * HALF + 4) * inv_scale;
#pragma unroll
            for (int ai = 0; ai < 2; ++ai)
#pragma unroll
                for (int m = 0; m < 4; ++m) { const size_t r = (size_t)(row0 + ai * HALF + m * 16);
                    const f32x4 v0 = acc[ai][bj][m][0] * c0, v1 = acc[ai][bj][m][1] * c1;
                    const u32x4 g = gl[bj][ai][m];
                    u32x4 w; w.x = cvt_pk_bf16(v0[0] * ::bflo(g.x), v0[1] * ::bfhi(g.x)); w.y = cvt_pk_bf16(v0[2] * ::bflo(g.y), v0[3] * ::bfhi(g.y));
                    w.z = cvt_pk_bf16(v1[0] * ::bflo(g.z), v1[1] * ::bfhi(g.z)); w.w = cvt_pk_bf16(v1[2] * ::bflo(g.w), v1[3] * ::bfhi(g.w));
                    *(u32x4*)(O + r * 2048 + col0 + bj * HALF) = w; }
        }
    }
};
struct EpiGlu8 {
    static constexpr bool PERM = true, AFTER_DRAIN = false;
    unsigned char* ws; size_t o_out, o_ya, o_gb, o_amax; float inv_scale, out_scale;
    __device__ __forceinline__ void operator()(const f32x4 (&acc)[2][2][4][2], const Unit& u, int wr, int wc, int fr, int fq) const {
        asm volatile("s_nop 15\n\ts_nop 15" ::: "memory");
        bf16_t* O = (bf16_t*)(ws + o_out); const bf16_t* YA = (const bf16_t*)(ws + o_ya); const bf16_t* GB = (const bf16_t*)(ws + o_gb); const float* AMAX = (const float*)(ws + o_amax);
        const int row0 = u.pm * BM + wr * 64 + fr, oc = u.pn * 128 + wc * 32 + 8 * fq, wrow = u.pn * BM + wc * 32 + 8 * fq;
        const f32x4 sa0 = *(const f32x4*)(AMAX + wrow) * inv_scale, sa1 = *(const f32x4*)(AMAX + wrow + 4) * inv_scale, sb0 = *(const f32x4*)(AMAX + wrow + HALF) * inv_scale, sb1 = *(const f32x4*)(AMAX + wrow + HALF + 4) * inv_scale;
        u32x4 yal[2][4], gbl[2][4];
#pragma unroll
        for (int ai = 0; ai < 2; ++ai)
#pragma unroll
            for (int m = 0; m < 4; ++m) { const size_t r = (size_t)(row0 + ai * HALF + m * 16); yal[ai][m] = *(const u32x4*)(YA + r * 2048 + oc); gbl[ai][m] = *(const u32x4*)(GB + r * 4096 + oc); }
        __builtin_amdgcn_sched_barrier(0);
#pragma unroll
        for (int ai = 0; ai < 2; ++ai)
#pragma unroll
            for (int m = 0; m < 4; ++m) { const size_t r = (size_t)(row0 + ai * HALF + m * 16);
                const u32x4 ya = yal[ai][m], gb = gbl[ai][m];
                const f32x4 a0 = acc[ai][0][m][0] * sa0, a1 = acc[ai][0][m][1] * sa1, b0 = acc[ai][1][m][0] * sb0, b1 = acc[ai][1][m][1] * sb1;
                float mv[8];
                mv[0] = ::bflo(ya.x) + ::bflo(gb.x) * (a0[0] * sgm(b0[0])); mv[1] = ::bfhi(ya.x) + ::bfhi(gb.x) * (a0[1] * sgm(b0[1]));
                mv[2] = ::bflo(ya.y) + ::bflo(gb.y) * (a0[2] * sgm(b0[2])); mv[3] = ::bfhi(ya.y) + ::bfhi(gb.y) * (a0[3] * sgm(b0[3]));
                mv[4] = ::bflo(ya.z) + ::bflo(gb.z) * (a1[0] * sgm(b1[0])); mv[5] = ::bfhi(ya.z) + ::bfhi(gb.z) * (a1[1] * sgm(b1[1]));
                mv[6] = ::bflo(ya.w) + ::bflo(gb.w) * (a1[2] * sgm(b1[2])); mv[7] = ::bfhi(ya.w) + ::bfhi(gb.w) * (a1[3] * sgm(b1[3]));
#pragma unroll
                for (int e = 0; e < 8; ++e) mv[e] = fminf(fmaxf(mv[e] * out_scale, -448.f), 448.f);
                int q0 = 0, q1 = 0; q0 = __builtin_amdgcn_cvt_pk_fp8_f32(mv[0], mv[1], q0, false); q0 = __builtin_amdgcn_cvt_pk_fp8_f32(mv[2], mv[3], q0, true);
                q1 = __builtin_amdgcn_cvt_pk_fp8_f32(mv[4], mv[5], q1, false); q1 = __builtin_amdgcn_cvt_pk_fp8_f32(mv[6], mv[7], q1, true);
                typedef unsigned u32x2 __attribute__((ext_vector_type(2)));
                *(u32x2*)((unsigned char*)O + r * 2048 + oc) = u32x2{(unsigned)q0, (unsigned)q1}; }
    }
};
struct EpiGateMul {
    static constexpr bool PERM = true, AFTER_DRAIN = false;
    bf16_t* O; int ldo; const bf16_t* G; int ldg;
    __device__ __forceinline__ void operator()(const f32x4 (&acc)[2][2][4][2], const Unit& u, int wr, int wc, int fr, int fq) const {
        const int row0 = u.pm * BM + wr * 64 + fr, col0 = u.pn * BM + wc * 32 + 8 * fq;
#pragma unroll
        for (int ai = 0; ai < 2; ++ai)
#pragma unroll
            for (int m = 0; m < 4; ++m) { const size_t r = (size_t)(row0 + ai * HALF + m * 16);
#pragma unroll
                for (int bj = 0; bj < 2; ++bj) { const f32x4 v0 = acc[ai][bj][m][0], v1 = acc[ai][bj][m][1];
                    const u32x4 g = *(const u32x4*)(G + r * ldg + col0 + bj * HALF);
                    u32x4 w; w.x = cvt_pk_bf16(v0[0] * ::bflo(g.x), v0[1] * ::bfhi(g.x)); w.y = cvt_pk_bf16(v0[2] * ::bflo(g.y), v0[3] * ::bfhi(g.y));
                    w.z = cvt_pk_bf16(v1[0] * ::bflo(g.z), v1[1] * ::bfhi(g.z)); w.w = cvt_pk_bf16(v1[2] * ::bflo(g.w), v1[3] * ::bfhi(g.w));
                    *(u32x4*)(O + r * ldo + col0 + bj * HALF) = w; } }
    }
};
struct EpiGlu {
    static constexpr bool PERM = true, AFTER_DRAIN = false;
    bf16_t* O; const bf16_t* YA; const bf16_t* GB; int ldg;
    __device__ __forceinline__ void operator()(const f32x4 (&acc)[2][2][4][2], const Unit& u, int wr, int wc, int fr, int fq) const {
        const int row0 = u.pm * BM + wr * 64 + fr, oc = u.pn * 128 + wc * 32 + 8 * fq;
#pragma unroll
        for (int ai = 0; ai < 2; ++ai)
#pragma unroll
            for (int m = 0; m < 4; ++m) { const size_t r = (size_t)(row0 + ai * HALF + m * 16);
                const u32x4 ya = *(const u32x4*)(YA + r * 2048 + oc), gb = *(const u32x4*)(GB + r * ldg + oc);
                const f32x4 a0 = acc[ai][0][m][0], a1 = acc[ai][0][m][1], b0 = acc[ai][1][m][0], b1 = acc[ai][1][m][1];
                u32x4 w;
                w.x = cvt_pk_bf16(::bflo(ya.x) + ::bflo(gb.x) * (a0[0] * sgm(b0[0])), ::bfhi(ya.x) + ::bfhi(gb.x) * (a0[1] * sgm(b0[1])));
                w.y = cvt_pk_bf16(::bflo(ya.y) + ::bflo(gb.y) * (a0[2] * sgm(b0[2])), ::bfhi(ya.y) + ::bfhi(gb.y) * (a0[3] * sgm(b0[3])));
                w.z = cvt_pk_bf16(::bflo(ya.z) + ::bflo(gb.z) * (a1[0] * sgm(b1[0])), ::bfhi(ya.z) + ::bfhi(gb.z) * (a1[1] * sgm(b1[1])));
                w.w = cvt_pk_bf16(::bflo(ya.w) + ::bflo(gb.w) * (a1[2] * sgm(b1[2])), ::bfhi(ya.w) + ::bfhi(gb.w) * (a1[3] * sgm(b1[3])));
                *(u32x4*)(O + r * 2048 + oc) = w; }
    }
};
struct EpiResid {
    static constexpr bool PERM = true, AFTER_DRAIN = false;
    const float* X; bf16_t* XB; float* SSQ;
    __device__ __forceinline__ void operator()(const f32x4 (&acc)[2][2][4][2], const Unit& u, int wr, int wc, int fr, int fq) const {
        const int row0 = u.pm * BM + wr * 64 + fr, col0 = u.pn * BM + wc * 32 + 8 * fq;
#pragma unroll
        for (int ai = 0; ai < 2; ++ai)
#pragma unroll
            for (int m = 0; m < 4; ++m) { const size_t r = (size_t)(row0 + ai * HALF + m * 16); float ss = 0.f;
#pragma unroll
                for (int bj = 0; bj < 2; ++bj) { const size_t off = r * 2048 + col0 + bj * HALF;
                    const f32x4 x0 = __builtin_nontemporal_load((const f32x4*)(X + off)) + acc[ai][bj][m][0], x1 = __builtin_nontemporal_load((const f32x4*)(X + off + 4)) + acc[ai][bj][m][1];
                    ss += ((x0[0] * x0[0] + x0[1] * x0[1]) + (x0[2] * x0[2] + x0[3] * x0[3])) + ((x1[0] * x1[0] + x1[1] * x1[1]) + (x1[2] * x1[2] + x1[3] * x1[3]));
                    u32x4 w; w.x = cvt_pk_bf16(x0[0], x0[1]); w.y = cvt_pk_bf16(x0[2], x0[3]); w.z = cvt_pk_bf16(x1[0], x1[1]); w.w = cvt_pk_bf16(x1[2], x1[3]); *(u32x4*)(XB + off) = w; }
                ss += __shfl_xor(ss, 16); ss += __shfl_xor(ss, 32);
                if (fq == 0) SSQ[r * 32 + u.pn * 4 + wc] = ss; }
    }
};
struct EpiResid8 {
    static constexpr bool PERM = true, AFTER_DRAIN = false;
    unsigned char* ws; const float* X; size_t o_xb, o_ssq, o_amax; float inv_scale;
    __device__ __forceinline__ void operator()(f32x4 (&acc)[2][2][4][2], const Unit& u, int wr, int wc, int fr, int fq) const {
        asm volatile("s_nop 15\n\ts_nop 15" ::: "memory");
        bf16_t* XB = (bf16_t*)(ws + o_xb); float* SSQ = (float*)(ws + o_ssq); const float* AMAX = (const float*)(ws + o_amax);
        const int row0 = u.pm * BM + wr * 64 + fr, col0 = u.pn * BM + wc * 32 + 8 * fq;
#pragma unroll
        for (int bj = 0; bj < 2; ++bj) { const f32x4 c0 = *(const f32x4*)(AMAX + col0 + bj * HALF) * inv_scale, c1 = *(const f32x4*)(AMAX + col0 + bj * HALF + 4) * inv_scale;
#pragma unroll
            for (int ai = 0; ai < 2; ++ai)
#pragma unroll
                for (int m = 0; m < 4; ++m) { acc[ai][bj][m][0] = acc[ai][bj][m][0] * c0; acc[ai][bj][m][1] = acc[ai][bj][m][1] * c1; } }
        __builtin_amdgcn_sched_barrier(0);
        f32x4 xv[2][2][2][2]; u32x4 w[2][2]; float ssv[2];
#define EPR_LOAD(q, B) _Pragma("unroll") for (int mm = 0; mm < 2; ++mm) _Pragma("unroll") for (int bj = 0; bj < 2; ++bj) { const size_t off = (size_t)(row0 + ((q) >> 1) * HALF + (2 * ((q) & 1) + mm) * 16) * 2048 + col0 + bj * HALF; \
            xv[B][mm][bj][0] = __builtin_nontemporal_load((const f32x4*)(X + off)); xv[B][mm][bj][1] = __builtin_nontemporal_load((const f32x4*)(X + off + 4)); }
#define EPR_COMP(q, B) _Pragma("unroll") for (int mm = 0; mm < 2; ++mm) { float ss = 0.f; _Pragma("unroll") for (int bj = 0; bj < 2; ++bj) { \
                const f32x4 x0 = xv[B][mm][bj][0] + acc[(q) >> 1][bj][2 * ((q) & 1) + mm][0], x1 = xv[B][mm][bj][1] + acc[(q) >> 1][bj][2 * ((q) & 1) + mm][1]; \
                ss += ((x0[0] * x0[0] + x0[1] * x0[1]) + (x0[2] * x0[2] + x0[3] * x0[3])) + ((x1[0] * x1[0] + x1[1] * x1[1]) + (x1[2] * x1[2] + x1[3] * x1[3])); \
                w[mm][bj].x = cvt_pk_bf16(x0[0], x0[1]); w[mm][bj].y = cvt_pk_bf16(x0[2], x0[3]); w[mm][bj].z = cvt_pk_bf16(x1[0], x1[1]); w[mm][bj].w = cvt_pk_bf16(x1[2], x1[3]); } \
            ss += __shfl_xor(ss, 16); ss += __shfl_xor(ss, 32); ssv[mm] = ss; }
#define EPR_STORE(q) _Pragma("unroll") for (int mm = 0; mm < 2; ++mm) { const size_t r = (size_t)(row0 + ((q) >> 1) * HALF + (2 * ((q) & 1) + mm) * 16); _Pragma("unroll") for (int bj = 0; bj < 2; ++bj) *(u32x4*)(XB + r * 2048 + col0 + bj * HALF) = w[mm][bj]; \
            if (fq == 0) SSQ[r * 32 + u.pn * 4 + wc] = ssv[mm]; }
#define EPR_SB __builtin_amdgcn_sched_barrier(0)
        EPR_LOAD(0, 0); EPR_LOAD(1, 1); EPR_SB;
        EPR_COMP(0, 0); EPR_SB; EPR_LOAD(2, 0); EPR_SB; EPR_STORE(0); EPR_SB;
        EPR_COMP(1, 1); EPR_SB; EPR_LOAD(3, 1); EPR_SB; EPR_STORE(1); EPR_SB;
        EPR_COMP(2, 0); EPR_SB; EPR_STORE(2); EPR_SB;
        EPR_COMP(3, 1); EPR_STORE(3);
#undef EPR_SB
#undef EPR_LOAD
#undef EPR_COMP
#undef EPR_STORE
    }
};
struct EpiPlain {
    static constexpr bool PERM = true, AFTER_DRAIN = false;
    bf16_t* O; int ldo;
    __device__ __forceinline__ void operator()(const f32x4 (&acc)[2][2][4][2], const Unit& u, int wr, int wc, int fr, int fq) const {
        const int row0 = u.pm * BM + wr * 64 + fr, col0 = u.pn * BM + wc * 32 + 8 * fq;
#pragma unroll
        for (int ai = 0; ai < 2; ++ai)
#pragma unroll
            for (int m = 0; m < 4; ++m) { bf16_t* rowp = O + (size_t)(row0 + ai * HALF + m * 16) * ldo + col0;
#pragma unroll
                for (int bj = 0; bj < 2; ++bj) { const f32x4 v0 = acc[ai][bj][m][0], v1 = acc[ai][bj][m][1];
                    u32x4 w; w.x = cvt_pk_bf16(v0[0], v0[1]); w.y = cvt_pk_bf16(v0[2], v0[3]); w.z = cvt_pk_bf16(v1[0], v1[1]); w.w = cvt_pk_bf16(v1[2], v1[3]);
                    *(u32x4*)(rowp + bj * HALF) = w; } }
    }
};

template <class Epi, class Sched, bool ALIGN_EPI = false, bool SP2 = false, bool FP8 = false>
__device__ __forceinline__ void gemm_phase(PG8_LAS unsigned char* lds, const Gemm g, const Sched& S, const Epi& E) {
    const int tid = threadIdx.x, wid = __builtin_amdgcn_readfirstlane(tid >> 6), lane = tid & 63, wr = wid >> 2, wc = wid & 3, fr = lane & 15, fq = lane >> 4;
    const int K = g.K, nt = K / BK;
    unsigned voffA[2], voffB[2];
#pragma unroll
    for (int i = 0; i < 2; ++i) { int R, C; stage_rc(tid * 16 + i * 8192, R, C); const int Rb = Epi::PERM ? ((R & ~31) + perm32(R & 31)) : R;
        voffA[i] = g.amode ? (unsigned)(R * 16 + (C >> 3) * 32768) : (unsigned)(R * K + C) * 2u; voffB[i] = (unsigned)(Rb * K + C) * 2u; }
    const size_t kstep = (size_t)(BK * 2);
    const size_t hstep = (size_t)HALF * K * 2;
    const size_t tstep = 2 * hstep;
    const size_t kstepA = g.amode ? (size_t)262144 : kstep, hstepA = g.amode ? (size_t)2048 : hstep;
    auto tileA = [&](int pm) -> const char* { return g.amode ? (const char*)g.A + (size_t)(pm >> 3) * 2097152 + (size_t)(pm & 7) * 4096 : (const char*)g.A + (size_t)pm * tstep; };
    const unsigned ldsw = (unsigned)wid * 1024u;
    const int aoff = lds_byte(wr * 64 + fr, fq * 8), boff = lds_byte(wc * 32 + fr, fq * 8);
#define PG8_SA(b, h) (((b) * 2 + (h)) * HTB)
#define PG8_SB(b, h) ((4 + (b) * 2 + (h)) * HTB)
#define PG8_STAGE(bufoff, gbase, voff) do { _Pragma("unroll") for (int _i = 0; _i < 2; ++_i) \
        __builtin_amdgcn_global_load_lds((const unsigned*)((const char*)(gbase) + (voff)[_i]), (PG8_LAS unsigned*)(lds + (bufoff) + ldsw + _i * 8192), 16, 0, 0); } while (0)
#define PG8_LD8(p) __builtin_shufflevector(*(const PG8_LAS v4i_t*)(p), *(const PG8_LAS v4i_t*)((p) + 1024), 0, 1, 2, 3, 4, 5, 6, 7)
#define PG8_LDA(dst, b, h) do { if constexpr (FP8) { _Pragma("unroll") for (int m = 0; m < 4; ++m) dst##8[m] = PG8_LD8(lds + PG8_SA(b, h) + aoff + m * 2048); } \
        else { _Pragma("unroll") for (int m = 0; m < 4; ++m) _Pragma("unroll") for (int k = 0; k < 2; ++k) dst[m][k] = *(const PG8_LAS bf16x8*)(lds + PG8_SA(b, h) + aoff + m * 2048 + k * 1024); } } while (0)
#define PG8_LDB(dst, b, h) do { if constexpr (FP8) { _Pragma("unroll") for (int n = 0; n < 2; ++n) dst##8[n] = PG8_LD8(lds + PG8_SB(b, h) + boff + n * 2048); } \
        else { _Pragma("unroll") for (int n = 0; n < 2; ++n) _Pragma("unroll") for (int k = 0; k < 2; ++k) dst[n][k] = *(const PG8_LAS bf16x8*)(lds + PG8_SB(b, h) + boff + n * 2048 + k * 1024); } } while (0)
#define PG8_CAT8(x0, x1) __builtin_shufflevector(__builtin_bit_cast(v4i_t, (x0)), __builtin_bit_cast(v4i_t, (x1)), 0, 1, 2, 3, 4, 5, 6, 7)
#define PG8_MMA(ai, bj, At, Bt) do { __builtin_amdgcn_s_setprio(1); if constexpr (FP8) asm volatile("s_nop 1" ::: "memory"); _Pragma("unroll") for (int m = 0; m < 4; ++m) _Pragma("unroll") for (int n = 0; n < 2; ++n) { \
        if constexpr (FP8) asm volatile("v_mfma_f32_16x16x128_f8f6f4 %0, %1, %2, %0" : "+v"(acc[ai][bj][m][n]) : "v"(Bt##8[n]), "v"(At##8[m])); \
        else { _Pragma("unroll") for (int k = 0; k < 2; ++k) acc[ai][bj][m][n] = __builtin_amdgcn_mfma_f32_16x16x32_bf16(Bt[n][k], At[m][k], acc[ai][bj][m][n], 0, 0, 0); } } \
        __builtin_amdgcn_s_setprio(0); } while (0)
#define PG8_WAIT_V(n) asm volatile("s_waitcnt vmcnt(" #n ")" ::: "memory")
#define PG8_WAIT_L(n) asm volatile("s_waitcnt lgkmcnt(" #n ")" ::: "memory")
#define PG8_BAR __builtin_amdgcn_s_barrier()
#define PG8_SCHED __builtin_amdgcn_sched_barrier(0)
    Unit cur, nxt; int ui = 0;
    if (!S.next(0, cur)) return;
    f32x4 acc[2][2][4][2];
#pragma unroll
    for (int a = 0; a < 2; ++a)
#pragma unroll
        for (int b = 0; b < 2; ++b)
#pragma unroll
            for (int m = 0; m < 4; ++m)
#pragma unroll
                for (int n = 0; n < 2; ++n) acc[a][b][m][n] = (f32x4){0.f, 0.f, 0.f, 0.f};
    bf16x8 At[4][2], B0[2][2], B1[2][2]; v8i_t At8[4], B08[2], B18[2];
    const char* cA = tileA(cur.pm); const char* cB = (const char*)g.Bt + (size_t)cur.pn * tstep;
    S.a_ready(cur);
    if constexpr (SP2) {
        PG8_STAGE(PG8_SB(0, 0), cB, voffB); PG8_STAGE(PG8_SB(0, 1), cB + hstep, voffB); PG8_STAGE(PG8_SA(0, 0), cA, voffA); PG8_STAGE(PG8_SA(0, 1), cA + hstepA, voffA);
        if (wr == 1) PG8_BAR;
        PG8_WAIT_V(2); PG8_BAR;
        PG8_STAGE(PG8_SB(1, 0), cB + kstep, voffB); PG8_STAGE(PG8_SA(1, 0), cA + kstepA, voffA); PG8_STAGE(PG8_SB(1, 1), cB + hstep + kstep, voffB);
        PG8_WAIT_V(6); PG8_BAR;
    } else {
        PG8_STAGE(PG8_SB(0, 0), cB, voffB); PG8_STAGE(PG8_SA(0, 0), cA, voffA); PG8_STAGE(PG8_SB(0, 1), cB + hstep, voffB); PG8_STAGE(PG8_SA(0, 1), cA + hstepA, voffA);
        if (wr == 1) PG8_BAR;
        PG8_WAIT_V(4); PG8_BAR;
        PG8_STAGE(PG8_SB(1, 0), cB + kstep, voffB); PG8_STAGE(PG8_SA(1, 0), cA + kstepA, voffA); PG8_STAGE(PG8_SB(1, 1), cB + hstep + kstep, voffB);
        PG8_WAIT_V(6); PG8_BAR;
    }
    for (;;) {
        const bool has_next = S.next(ui + 1, nxt);
        const char* nA = has_next ? tileA(nxt.pm) : cA; const char* nB = has_next ? (const char*)g.Bt + (size_t)nxt.pn * tstep : cB;
        for (int t = 0; t < nt; t += 2) {
            const bool last = (t == nt - 2);
            const char* a1 = cA + (size_t)(t + 1) * kstepA;
            const char* a2 = last ? nA : cA + (size_t)(t + 2) * kstepA; const char* b2 = last ? nB : cB + (size_t)(t + 2) * kstep;
            const char* a3 = a2 + kstepA; const char* b3 = b2 + kstep;
            if (last && has_next) S.a_ready(nxt);
            if constexpr (SP2) {
            PG8_LDB(B0, 0, 0); PG8_LDB(B1, 0, 1); PG8_SCHED; PG8_LDA(At, 0, 0); PG8_STAGE(PG8_SA(1, 1), a1 + hstepA, voffA);
            PG8_WAIT_V(8); PG8_WAIT_L(0); PG8_BAR; PG8_MMA(0, 0, At, B0); PG8_MMA(0, 1, At, B1); PG8_BAR; PG8_SCHED;
            PG8_LDA(At, 0, 1); PG8_STAGE(PG8_SB(0, 0), b2, voffB); PG8_STAGE(PG8_SB(0, 1), b2 + hstep, voffB); PG8_STAGE(PG8_SA(0, 0), a2, voffA);
            PG8_WAIT_V(8); PG8_WAIT_L(0); PG8_BAR; PG8_MMA(1, 0, At, B0); PG8_MMA(1, 1, At, B1); PG8_BAR; PG8_SCHED;
            PG8_LDB(B0, 1, 0); PG8_LDB(B1, 1, 1); PG8_SCHED; PG8_LDA(At, 1, 0); PG8_STAGE(PG8_SA(0, 1), a2 + hstepA, voffA);
            PG8_WAIT_V(8); PG8_WAIT_L(0); PG8_BAR; PG8_MMA(0, 0, At, B0); PG8_MMA(0, 1, At, B1); PG8_BAR; PG8_SCHED;
            PG8_LDA(At, 1, 1); PG8_STAGE(PG8_SB(1, 0), b3, voffB); PG8_STAGE(PG8_SB(1, 1), b3 + hstep, voffB); PG8_STAGE(PG8_SA(1, 0), a3, voffA);
            PG8_WAIT_V(8); PG8_WAIT_L(0); PG8_BAR; PG8_MMA(1, 0, At, B0); PG8_MMA(1, 1, At, B1); PG8_BAR; PG8_SCHED;
            } else {
            PG8_LDB(B0, 0, 0); PG8_SCHED; PG8_LDA(At, 0, 0); PG8_STAGE(PG8_SA(1, 1), a1 + hstepA, voffA);
            PG8_WAIT_L(8); PG8_BAR; PG8_WAIT_L(0); PG8_MMA(0, 0, At, B0); PG8_BAR; PG8_SCHED;
            PG8_LDB(B1, 0, 1); PG8_STAGE(PG8_SB(0, 0), b2, voffB);
            PG8_BAR; PG8_WAIT_L(0); PG8_MMA(0, 1, At, B1); PG8_BAR;
            PG8_LDA(At, 0, 1); PG8_STAGE(PG8_SA(0, 0), a2, voffA);
            PG8_BAR; PG8_WAIT_L(0); PG8_MMA(1, 0, At, B0); PG8_BAR; PG8_SCHED;
            PG8_STAGE(PG8_SB(0, 1), b2 + hstep, voffB);
            PG8_WAIT_V(6); PG8_BAR; PG8_MMA(1, 1, At, B1); PG8_BAR;
            PG8_LDB(B0, 1, 0); PG8_SCHED; PG8_LDA(At, 1, 0); PG8_STAGE(PG8_SA(0, 1), a2 + hstepA, voffA);
            PG8_WAIT_L(8); PG8_BAR; PG8_WAIT_L(0); PG8_MMA(0, 0, At, B0); PG8_BAR; PG8_SCHED;
            PG8_LDB(B1, 1, 1); PG8_STAGE(PG8_SB(1, 0), b3, voffB);
            PG8_BAR; PG8_WAIT_L(0); PG8_MMA(0, 1, At, B1); PG8_BAR;
            PG8_LDA(At, 1, 1); PG8_STAGE(PG8_SA(1, 0), a3, voffA);
            PG8_BAR; PG8_WAIT_L(0); PG8_MMA(1, 0, At, B0); PG8_BAR; PG8_SCHED;
            PG8_STAGE(PG8_SB(1, 1), b3 + hstep, voffB);
            PG8_WAIT_V(6); PG8_BAR; PG8_MMA(1, 1, At, B1); PG8_BAR;
            }
        }
        if constexpr (ALIGN_EPI) { if (wr == 0) PG8_BAR; }
        if constexpr (!Epi::AFTER_DRAIN) { E(acc, cur, wr, wc, fr, fq); S.done(cur); }
        if (!has_next) break;
#pragma unroll
        for (int a = 0; a < 2; ++a)
#pragma unroll
            for (int b = 0; b < 2; ++b)
#pragma unroll
                for (int m = 0; m < 4; ++m)
#pragma unroll
                    for (int n = 0; n < 2; ++n) acc[a][b][m][n] = (f32x4){0.f, 0.f, 0.f, 0.f};
        cur = nxt; cA = nA; cB = nB; ++ui;
        if constexpr (ALIGN_EPI) { if (wr == 1) PG8_BAR; }
    }
    PG8_WAIT_V(0);
    if constexpr (!ALIGN_EPI) { if (wr == 0) PG8_BAR; }
    PG8_BAR;
    if constexpr (Epi::AFTER_DRAIN) { E.fused(acc, cur, wr, wc, fr, fq, lds, wid, lane); S.done(cur); }
#undef PG8_SA
#undef PG8_SB
#undef PG8_STAGE
#undef PG8_LDA
#undef PG8_LDB
#undef PG8_MMA
#undef PG8_WAIT_V
#undef PG8_WAIT_L
#undef PG8_BAR
#undef PG8_SCHED
}
}
constexpr size_t MiB = 1u << 20;
constexpr size_t WS_CTL = 0, CTL_ZERO_BYTES = 1 * MiB;
constexpr size_t WS_WIN = 2 * MiB, WS_WAO = 34 * MiB, WS_WGLU = 42 * MiB, WS_WOUT = 50 * MiB, WS_WPQ = 58 * MiB;
constexpr size_t WS_SSM = 66 * MiB;
constexpr size_t WS_IDX = 106 * MiB, WS_GATE = 122 * MiB, WS_SSQ = 138 * MiB;
constexpr size_t WS_BUFA = 144 * MiB, WS_BUFB = 272 * MiB, WS_YACT = 400 * MiB;
constexpr size_t WS_Q = 464 * MiB, WS_KV = 592 * MiB, WS_U = 656 * MiB, WS_GT = 720 * MiB;
constexpr size_t WS_DOWNB = 720 * MiB, WS_UPB = 784 * MiB;
constexpr size_t WS_END = 980 * MiB;
constexpr size_t WS_W8 = 272 * MiB + 64 * MiB, WS_HS = 102 * MiB;
constexpr size_t WS_H8 = WS_BUFB;
constexpr int CW_AMAX = 131072;
constexpr size_t WS_WAO8 = 91 * MiB, WS_WGLU8 = 95 * MiB;
constexpr int CW_AMAX_AO = CW_AMAX + 8192, CW_AMAX_GLU = CW_AMAX + 8192 + 2048, CW_AMAX_OUT = CW_AMAX + 8192 + 2048 + 4096;
constexpr float O8_SCALE = 64.f, Y8_SCALE = 16.f, M8_SCALE = 64.f;
constexpr size_t WS_WOUT8 = 976 * MiB;
constexpr int CW_BAR = 4096;

constexpr int RING_OFF = 0, RING_BYTES = 131072;
constexpr int LDS_BYTES = 163840;
constexpr int LDSCTL_OFF = LDS_BYTES - 1024, MISC_OFF = LDSCTL_OFF + 320;
constexpr int NWAVES = 8;

#define XB_TMO      128
#define XB_XCNT(j)  (256  + 64 * (j))
#define XB_XSUB(j)  (1280 + 64 * (j))
#define XB_XGEN(j)  (2304 + 64 * (j))
#define XB_TOP      3328
#define XB_TOPGEN   3392
#define XCD_BAR_WORDS 3456
#define XB_SPIN_CAP (1u << 23)

__device__ __forceinline__ unsigned xb_ld(unsigned* p)              { return __hip_atomic_load(p, __ATOMIC_RELAXED, __HIP_MEMORY_SCOPE_AGENT); }
__device__ __forceinline__ unsigned xb_add(unsigned* p, unsigned v) { return __hip_atomic_fetch_add(p, v, __ATOMIC_RELAXED, __HIP_MEMORY_SCOPE_AGENT); }
__device__ __forceinline__ unsigned xb_xcc_id() { return (unsigned)__builtin_amdgcn_s_getreg((3 << 11) | 20) & 0xFu; }
#define XB_SPIN(cond, bar) do { unsigned _sp = 0; while (cond) { __builtin_amdgcn_s_sleep(1); \
    if ((++_sp & 255u) == 0u) { if (xb_ld(&(bar)[XB_TMO])) break; if (_sp > XB_SPIN_CAP) { atomicAdd(&(bar)[XB_TMO], 1u); break; } } } } while (0)

struct XcdBarrier {
    unsigned* bar; unsigned x;
    volatile LAS unsigned* st;
};

__device__ __forceinline__ XcdBarrier xcd_barrier_post(unsigned* bar, volatile LAS unsigned* st) {
    XcdBarrier b; b.bar = bar; b.x = xb_xcc_id(); b.st = st;
    if (threadIdx.x == 0) (void)xb_add(&bar[XB_XCNT(b.x)], 1u);
    return b;
}
__device__ __forceinline__ void xcd_barrier_complete(unsigned* bar, unsigned x, unsigned& nloc, unsigned& nx) {
    const unsigned G = gridDim.x * gridDim.y * gridDim.z;
    unsigned sum, cnt, mine, sp = 0u;
    for (;;) {
        sum = 0u; cnt = 0u; mine = 0u;
#pragma unroll
        for (unsigned j = 0; j < 16; ++j) { const unsigned c = xb_ld(&bar[XB_XCNT(j)]); sum += c; cnt += (c > 0u) ? 1u : 0u; mine = (j == x) ? c : mine; }
        if (sum == G) break;
        __builtin_amdgcn_s_sleep(1);
        if ((++sp & 255u) == 0u) { if (xb_ld(&bar[XB_TMO])) break; if (sp > XB_SPIN_CAP) { atomicAdd(&bar[XB_TMO], 1u); break; } }
    }
    nloc = mine > 0u ? mine : 1u; nx = cnt > 0u ? cnt : 1u;
}

__device__ __forceinline__ void xcd_barrier(const XcdBarrier& b) {
    asm volatile("s_waitcnt vmcnt(0)" ::: "memory");
    __syncthreads();
    if (threadIdx.x == 0) {
        unsigned* bar = b.bar;
        __builtin_amdgcn_s_waitcnt(0);
        unsigned nloc = b.st[0], nx = b.st[1];
        if (nloc == 0u) { xcd_barrier_complete(bar, b.x, nloc, nx); b.st[0] = nloc; b.st[1] = nx; }
        const unsigned old = xb_add(&bar[XB_XSUB(b.x)], 1u);
        const unsigned gen = old / nloc;
        if (old + 1u == (gen + 1u) * nloc) {
            __builtin_amdgcn_fence(__ATOMIC_RELEASE, "agent");
            asm volatile("s_waitcnt vmcnt(0)" ::: "memory");
            const unsigned og = xb_add(&bar[XB_TOP], 1u);
            const unsigned tg = og / nx;
            if (og + 1u == (tg + 1u) * nx) xb_add(&bar[XB_TOPGEN], 1u);
            else XB_SPIN(xb_ld(&bar[XB_TOPGEN]) == tg, bar);
            __builtin_amdgcn_fence(__ATOMIC_ACQUIRE, "agent");
            xb_add(&bar[XB_XGEN(b.x)], 1u);
            asm volatile("s_waitcnt vmcnt(0)" ::: "memory");
        } else {
            XB_SPIN(xb_ld(&bar[XB_XGEN(b.x)]) == gen, bar);
            __builtin_amdgcn_fence(__ATOMIC_ACQUIRE, "agent");
            asm volatile("s_waitcnt vmcnt(0)" ::: "memory");
        }
    }
    __syncthreads();
}

#define XB_ALIGN(j) (3520 + 64 * (j))
__device__ __forceinline__ void xcd_align(const XcdBarrier& b) {
    __syncthreads();
    if (threadIdx.x == 0) {
        unsigned nloc = b.st[0]; if (nloc == 0u) nloc = 1u;
        unsigned* ctr = &b.bar[XB_ALIGN(b.x)];
        const unsigned old = xb_add(ctr, 1u); const unsigned target = (old / nloc + 1u) * nloc;
        unsigned sp = 0; while (xb_ld(ctr) < target) { __builtin_amdgcn_s_sleep(1); if (++sp > (1u << 20)) break; }
    }
    __syncthreads();
}
struct Frame {
    LAS unsigned char* lds;
    volatile LAS unsigned* MISC;
    gu32* ctl;
    int tid, lane, wave;
    int vcu, G;
    const float* const* in; float* out; unsigned char* ws;
};
#define IN_X 0
#define IN_MIXG 1
#define IN_WIN 2
#define IN_QG 3
#define IN_KG 4
#define IN_SINK 5
#define IN_WAO 6
#define IN_ARE 7
#define IN_AIM 8
#define IN_LSTEP 9
#define IN_BRE 10
#define IN_BIM 11
#define IN_CRE 12
#define IN_CIM 13
#define IN_SSMD 14
#define IN_GLUA 15
#define IN_GLUB 16
#define IN_WOUT 17
#define IN_FFNG 18
#define IN_PWQ 19
#define IN_SK1 20
#define IN_SK2 21
#define IN_PDOWN 22
#define IN_PUP 23

__device__ __forceinline__ int glu_row(int j, int isb) { return 256 * (j >> 7) + 128 * isb + (j & 127); }
__device__ __forceinline__ void p0_transpose_item(const float* W, int K, int N, bf16* WT, int mode, const float* gk, LAS float* scr, int item, int lane, unsigned* amaxw = nullptr, int amax_col0 = 0) {
    const int nblk = N / 32, kb = item / nblk, nb = item % nblk, k0 = 64 * kb, n0 = 32 * nb;
#pragma unroll 8
    for (int i = 0; i < 32; ++i) { const int kk = 2 * i + (lane >> 5); float w = __builtin_nontemporal_load(W + (size_t)(k0 + kk) * N + n0 + (lane & 31)); if (gk) w *= gk[k0 + kk]; scr[kk * 33 + (lane & 31)] = w; }
    LDS_WAIT(); asm volatile("" ::: "memory");
    const int c = lane & 7;
#pragma unroll
    for (int j = 0; j < 4; ++j) { const int n = (lane >> 3) + 8 * j; const LAS float* s = scr + (8 * c) * 33 + n;
        v4u o; o.x = pk2(s[0 * 33], s[1 * 33]); o.y = pk2(s[2 * 33], s[3 * 33]); o.z = pk2(s[4 * 33], s[5 * 33]); o.w = pk2(s[6 * 33], s[7 * 33]);
        const int sc = n0 + n, drow = (mode == 0) ? sc : glu_row(sc, mode - 1);
        *(GAS v4u*)(WT + (size_t)drow * K + k0 + 8 * c) = o;
        if (amaxw) {
            float mx = fmaxf(fmaxf(fmaxf(fabsf(s[0 * 33]), fabsf(s[1 * 33])), fmaxf(fabsf(s[2 * 33]), fabsf(s[3 * 33]))), fmaxf(fmaxf(fabsf(s[4 * 33]), fabsf(s[5 * 33])), fmaxf(fabsf(s[6 * 33]), fabsf(s[7 * 33]))));
            mx = fmaxf(mx, __shfl_xor(mx, 1)); mx = fmaxf(mx, __shfl_xor(mx, 2)); mx = fmaxf(mx, __shfl_xor(mx, 4));
            if (c == 0) atomicMax(amaxw + (drow - amax_col0), __float_as_uint(mx)); } }
    LDS_WAIT(); asm volatile("" ::: "memory");
}
__device__ __forceinline__ void rms_row_to_bf16(int lane, const float* xrow, const float* g, bf16* orow, unsigned char* o8row, float* hs) {
    const GAS f32x4* xr = (const GAS f32x4*)xrow + lane; const GAS f32x4* gr = (const GAS f32x4*)g + lane;
    f32x4 v[8]; float s = 0.f;
#pragma unroll
    for (int j = 0; j < 8; ++j) { v[j] = xr[64 * j]; s += (v[j].x * v[j].x + v[j].y * v[j].y) + (v[j].z * v[j].z + v[j].w * v[j].w); }
    const float rs = 1.0f / sqrtf(wave_sum(s) * (1.f / D_MODEL) + RMS_EPS);
    (void)orow;
    float amax = 0.f;
#pragma unroll
    for (int j = 0; j < 8; ++j) { const f32x4 gg = gr[64 * j]; v[j] = f32x4{v[j].x * rs * gg.x, v[j].y * rs * gg.y, v[j].z * rs * gg.z, v[j].w * rs * gg.w};
        amax = fmaxf(amax, fmaxf(fmaxf(fabsf(v[j].x), fabsf(v[j].y)), fmaxf(fabsf(v[j].z), fabsf(v[j].w)))); }
    amax = wave_max(amax); const float inv = amax > 0.f ? 448.f / amax : 0.f;
    if (lane == 0) *hs = amax * (1.f / 448.f);
#pragma unroll
    for (int j = 0; j < 8; ++j) { int q = 0; q = __builtin_amdgcn_cvt_pk_fp8_f32(v[j].x * inv, v[j].y * inv, q, false); q = __builtin_amdgcn_cvt_pk_fp8_f32(v[j].z * inv, v[j].w * inv, q, true);
        *(unsigned*)(o8row + 256 * j + 4 * lane) = (unsigned)q; }
}
__device__ __forceinline__ void p0_prologue(Frame& F, const int parts = 3) {
    LAS float* scr = (LAS float*)(F.lds + RING_OFF + F.wave * 16384);
    const int gw = F.vcu * NWAVES + F.wave, NGW = F.G * NWAVES;
    constexpr int I_IN = (2048 / 64) * (8192 / 32), I_SQ = (2048 / 64) * (2048 / 32), I_GL = (1024 / 64) * (2048 / 32);
    constexpr int NITEMS = I_IN + 3 * I_SQ + 2 * I_GL;
    unsigned char* ws = F.ws;
    if (parts & 1) for (int it = gw; it < NITEMS; it += NGW) {
        int r = it;
        if (r < I_IN) { p0_transpose_item(F.in[IN_WIN], 2048, 8192, (bf16*)(ws + WS_WIN), 0, nullptr, scr, r, F.lane, (unsigned*)F.ctl + CW_AMAX, 0); continue; } r -= I_IN;
        if (r < I_SQ) { p0_transpose_item(F.in[IN_WAO], 2048, 2048, (bf16*)(ws + WS_WAO), 0, nullptr, scr, r, F.lane, (unsigned*)F.ctl + CW_AMAX_AO, 0); continue; } r -= I_SQ;
        if (r < I_SQ) { p0_transpose_item(F.in[IN_WOUT], 2048, 2048, (bf16*)(ws + WS_WOUT), 0, nullptr, scr, r, F.lane, (unsigned*)F.ctl + CW_AMAX_OUT, 0); continue; } r -= I_SQ;
        if (r < I_SQ) { p0_transpose_item(F.in[IN_PWQ], 2048, 2048, (bf16*)(ws + WS_WPQ), 0, F.in[IN_FFNG], scr, r, F.lane); continue; } r -= I_SQ;
        if (r < I_GL) { p0_transpose_item(F.in[IN_GLUA], 1024, 2048, (bf16*)(ws + WS_WGLU), 1, nullptr, scr, r, F.lane, (unsigned*)F.ctl + CW_AMAX_GLU, 0); continue; } r -= I_GL;
        p0_transpose_item(F.in[IN_GLUB], 1024, 2048, (bf16*)(ws + WS_WGLU), 2, nullptr, scr, r, F.lane, (unsigned*)F.ctl + CW_AMAX_GLU, 0);
    }
    bf16* H = (bf16*)(ws + WS_BUFA);
    if (parts & 2) for (int m = gw; m < T_TOK; m += NGW) rms_row_to_bf16(F.lane, F.in[IN_X] + (size_t)m * D_MODEL, F.in[IN_MIXG], H + (size_t)m * D_MODEL, F.ws + WS_H8 + (size_t)m * D_MODEL, (float*)(F.ws + WS_HS) + m);
}

__device__ __forceinline__ void w8_convert_one(Frame& F, const v4u* WT, v2u* W8, const float* AMAX, size_t n8, int shift) {
    const size_t gt = (size_t)F.vcu * 512 + F.tid, NT = (size_t)F.G * 512;
    for (size_t i = gt; i < n8; i += NT) { const float am = AMAX[i >> shift], inv = am > 0.f ? 440.f / am : 0.f; const v4u w = WT[i];
        int q0 = 0, q1 = 0; q0 = __builtin_amdgcn_cvt_pk_fp8_f32(bflo(w.x) * inv, bfhi(w.x) * inv, q0, false); q0 = __builtin_amdgcn_cvt_pk_fp8_f32(bflo(w.y) * inv, bfhi(w.y) * inv, q0, true);
        q1 = __builtin_amdgcn_cvt_pk_fp8_f32(bflo(w.z) * inv, bfhi(w.z) * inv, q1, false); q1 = __builtin_amdgcn_cvt_pk_fp8_f32(bflo(w.w) * inv, bfhi(w.w) * inv, q1, true);
        W8[i] = v2u{(unsigned)q0, (unsigned)q1}; }
}
__device__ __forceinline__ void w8_convert_phase(Frame& F) {
    const float* AM = (const float*)((unsigned*)F.ctl);
    w8_convert_one(F, (const v4u*)(F.ws + WS_WIN), (v2u*)(F.ws + WS_W8), AM + CW_AMAX, (size_t)8192 * 2048 / 8, 8);
    w8_convert_one(F, (const v4u*)(F.ws + WS_WAO), (v2u*)(F.ws + WS_WAO8), AM + CW_AMAX_AO, (size_t)2048 * 2048 / 8, 8);
    w8_convert_one(F, (const v4u*)(F.ws + WS_WGLU), (v2u*)(F.ws + WS_WGLU8), AM + CW_AMAX_GLU, (size_t)4096 * 1024 / 8, 7);
    w8_convert_one(F, (const v4u*)(F.ws + WS_WOUT), (v2u*)(F.ws + WS_WOUT8), AM + CW_AMAX_OUT, (size_t)2048 * 2048 / 8, 8);
}

namespace ssm {
using bf16x8 = __attribute__((ext_vector_type(8))) short;
using f32x16 = __attribute__((ext_vector_type(16))) float;
constexpr size_t WS_FR1 = WS_SSM, WS_FR3 = WS_SSM + 8 * MiB, WS_SC = WS_SSM + 24 * MiB;
constexpr int CHS = 528, L_U = 0, L_XZ = 128 * CHS;
typedef float cf __attribute__((ext_vector_type(2)));
__device__ __forceinline__ cf cmul(cf a, cf b) { return cf{a.x * b.x - a.y * b.y, a.x * b.y + a.y * b.x}; }
__device__ __forceinline__ void precompute_group(Frame& F, int g, int part) {
    LAS cf* POW = (LAS cf*)(F.lds);
    LAS cf* BB = (LAS cf*)(F.lds + 17408);
    LAS cf* CC = (LAS cf*)(F.lds + 33792);
    LAS float* KT = (LAS float*)(F.lds + 50176);
    const int tid = F.tid;
    for (int idx = tid; idx < 2 * 17 * 64; idx += 512) { const int dir = idx / (17 * 64), d = (idx >> 6) % 17, n = idx & 63, pg = dir * 64 + g;
        const float are = F.in[IN_ARE][pg * 64 + n], aim = F.in[IN_AIM][pg * 64 + n], step = expf(F.in[IN_LSTEP][pg]);
        const float mag = expf((float)d * are * step), ang = (float)d * aim * step; POW[idx] = cf{mag * cosf(ang), mag * sinf(ang)}; }
    for (int idx = tid; idx < 2 * 64 * 16; idx += 512) { const int dir = idx >> 10, n = (idx >> 4) & 63, c = idx & 15, pg = dir * 64 + g;
        const float are = F.in[IN_ARE][pg * 64 + n], aim = F.in[IN_AIM][pg * 64 + n], step = expf(F.in[IN_LSTEP][pg]);
        const float mag = expf(are * step), ang = aim * step; const float lr = mag * cosf(ang), li = mag * sinf(ang);
        const float nr = lr - 1.f, ni = li, den = are * are + aim * aim; const cf f{(nr * are + ni * aim) / den, (ni * are - nr * aim) / den};
        BB[idx] = cmul(f, cf{F.in[IN_BRE][((size_t)pg * 64 + n) * 16 + c], F.in[IN_BIM][((size_t)pg * 64 + n) * 16 + c]}); }
    for (int idx = tid; idx < 2 * 16 * 64; idx += 512) { const int dir = idx >> 10, pg = dir * 64 + g; CC[idx] = cf{F.in[IN_CRE][(size_t)pg * 1024 + (idx & 1023)], F.in[IN_CIM][(size_t)pg * 1024 + (idx & 1023)]}; }
    LDS_WAIT(); __syncthreads();
    { const int dir = tid >> 8, d = (tid >> 4) & 15, c = tid & 15; float s[16];
#pragma unroll
      for (int c2 = 0; c2 < 16; ++c2) s[c2] = 0.f;
      for (int n = 0; n < 64; ++n) { const cf t = cmul(CC[(dir * 16 + c) * 64 + n], POW[(dir * 17 + d) * 64 + n]);
#pragma unroll
          for (int c2 = 0; c2 < 16; ++c2) { const cf b = BB[(dir * 64 + n) * 16 + c2]; s[c2] += t.x * b.x - t.y * b.y; } }
#pragma unroll
      for (int c2 = 0; c2 < 16; ++c2) KT[((dir * 16 + d) * 16 + c) * 16 + c2] = s[c2]; }
    LDS_WAIT(); __syncthreads();
    v4u* FR1 = (v4u*)(F.ws + WS_FR1); v4u* FR3 = (v4u*)(F.ws + WS_FR3); float* SC = (float*)(F.ws + WS_SC);
    for (int task = part * 2048 + tid; task < (part + 1) * 2048; task += 512) { const int h = task & 1, ks = (task >> 1) & 15, sg = task >> 5, dir = sg >> 7, n = (sg >> 1) & 63, ri = sg & 1;
        const cf pw = dir == 0 ? POW[(0 * 17 + (15 - ks)) * 64 + n] : POW[(1 * 17 + ks) * 64 + n]; float v[8];
#pragma unroll
        for (int i = 0; i < 8; ++i) { const cf x = cmul(pw, BB[(dir * 64 + n) * 16 + 8 * h + i]); v[i] = ri ? x.y : x.x; }
        v4u o; o.x = pk2(v[0], v[1]); o.y = pk2(v[2], v[3]); o.z = pk2(v[4], v[5]); o.w = pk2(v[6], v[7]);
        FR1[(((size_t)g * 8 + (sg >> 5)) * 16 + ks) * 64 + (sg & 31) + 32 * h] = o; }
    for (int task = part * 4096 + tid; task < (part + 1) * 4096; task += 512) { const int h = task & 1, ks = (task >> 1) & 31, rho = task >> 6, t = rho >> 4, c = rho & 15; float v[8];
        if (ks < 16) {
#pragma unroll
            for (int i = 0; i < 8; ++i) { const int sg = 16 * ks + 8 * h + i, dir = sg >> 7, n = (sg >> 1) & 63, ri = sg & 1;
                const cf pw = dir == 0 ? POW[(0 * 17 + (t + 1)) * 64 + n] : POW[(1 * 17 + (16 - t)) * 64 + n]; const cf x = cmul(CC[(dir * 16 + c) * 64 + n], pw); v[i] = ri ? -x.y : x.x; }
        } else { const int j = ks - 16;
#pragma unroll
            for (int i = 0; i < 8; ++i) { const int c2 = 8 * h + i; float x;
                if (j < t) x = KT[((0 * 16 + (t - j)) * 16 + c) * 16 + c2]; else if (j > t) x = KT[((1 * 16 + (j - t)) * 16 + c) * 16 + c2];
                else x = KT[((0 * 16 + 0) * 16 + c) * 16 + c2] + KT[((1 * 16 + 0) * 16 + c) * 16 + c2] + (c == c2 ? F.in[IN_SSMD][g * 16 + c] : 0.f);
                v[i] = x; } }
        v4u o; o.x = pk2(v[0], v[1]); o.y = pk2(v[2], v[3]); o.z = pk2(v[4], v[5]); o.w = pk2(v[6], v[7]);
        FR3[(((size_t)g * 8 + (rho >> 5)) * 32 + ks) * 64 + (rho & 31) + 32 * h] = o; }
    if (part == 0 && tid < 256) { const int sg = tid, dir = sg >> 7, n = (sg >> 1) & 63, ri = sg & 1; const cf L16 = POW[(dir * 17 + 16) * 64 + n];
        SC[((size_t)g * 256 + sg) * 2] = L16.x; SC[((size_t)g * 256 + sg) * 2 + 1] = ri ? L16.y : -L16.y; }
    LDS_WAIT(); __syncthreads();
}
__device__ __forceinline__ float dpp_swap1(float x) { return __builtin_bit_cast(float, __builtin_amdgcn_update_dpp(0, __builtin_bit_cast(int, x), 0xB1, 0xF, 0xF, true)); }
__device__ __forceinline__ void unit(Frame& F, int b, int g) {
    const int tid = F.tid, w = F.wave, lane = F.lane, r32 = lane & 31, hi = lane >> 5;
    LAS char* lds = (LAS char*)F.lds;
    const bf16* U = (const bf16*)(F.ws + WS_U); bf16* YA = (bf16*)(F.ws + WS_YACT);
#pragma unroll
    for (int i = 0; i < 8; ++i) { const int pc = tid + 512 * i, s = pc >> 1, hf = pc & 1;
        const v4u v = *(const v4u*)(U + ((size_t)(b * 64 + g) * SEQ + s) * 16 + 8 * hf);
        *(LAS v4u*)(lds + L_U + (s >> 4) * CHS + ((s & 15) * 16 + 8 * hf) * 2) = v; }
    if (tid < 128) { *(LAS unsigned short*)(lds + L_XZ + tid * 2) = 0; *(LAS unsigned short*)(lds + L_XZ + 127 * CHS + (128 + tid) * 2) = 0; }
    LDS_WAIT(); __syncthreads();
    f32x16 acc[4] = {};
    { const bf16x8* fr1 = (const bf16x8*)(F.ws + WS_FR1) + ((size_t)g * 8 + w) * 16 * 64 + lane;
      int cA[4];
#pragma unroll
      for (int mt = 0; mt < 4; ++mt) cA[mt] = (64 * ((r32 >> 2) & 1) + 16 * mt + (r32 & 3) + 4 * (r32 >> 3)) * CHS + hi * 16;
#pragma unroll
      for (int ks = 0; ks < 16; ++ks) { const bf16x8 bfr = fr1[ks * 64];
#pragma unroll
          for (int mt = 0; mt < 4; ++mt) { const bf16x8 afr = *(LAS const bf16x8*)(lds + L_U + cA[mt] + ks * 32); acc[mt] = __builtin_amdgcn_mfma_f32_32x32x16_bf16(afr, bfr, acc[mt], 0, 0, 0); } } }
    { const float* SC = (const float*)(F.ws + WS_SC) + ((size_t)g * 256 + 32 * w + r32) * 2; const float ca = SC[0], cb = SC[1];
      LAS char* xz = lds + L_XZ + (32 * w + r32) * 2;
      float x = 0.f;
      if (w < 4) {
#pragma unroll
          for (int mt = 0; mt < 4; ++mt)
#pragma unroll
              for (int r = 0; r < 16; ++r) x = ca * x + cb * dpp_swap1(x) + acc[mt][r];
          const float c = __shfl_xor(x, 32); x = hi ? c : 0.f;
#pragma unroll
          for (int mt = 0; mt < 4; ++mt)
#pragma unroll
              for (int r = 0; r < 16; ++r) { x = ca * x + cb * dpp_swap1(x) + acc[mt][r]; const int k = 64 * hi + 16 * mt + r;
                  if (k + 1 <= 127) *(LAS unsigned short*)(xz + (k + 1) * CHS) = (unsigned short)(pk2(x, 0.f) & 0xffffu); }
      } else {
#pragma unroll
          for (int mt = 3; mt >= 0; --mt)
#pragma unroll
              for (int r = 15; r >= 0; --r) x = ca * x + cb * dpp_swap1(x) + acc[mt][r];
          const float c = __shfl_xor(x, 32); x = hi ? 0.f : c;
#pragma unroll
          for (int mt = 3; mt >= 0; --mt)
#pragma unroll
              for (int r = 15; r >= 0; --r) { x = ca * x + cb * dpp_swap1(x) + acc[mt][r]; const int k = 64 * hi + 16 * mt + r;
                  if (k >= 1) *(LAS unsigned short*)(xz + (k - 1) * CHS) = (unsigned short)(pk2(x, 0.f) & 0xffffu); }
      } }
    LDS_WAIT(); __syncthreads();
#pragma unroll
    for (int nt = 0; nt < 4; ++nt) acc[nt] = f32x16{};
    { const bf16x8* fr3 = (const bf16x8*)(F.ws + WS_FR3) + ((size_t)g * 8 + w) * 32 * 64 + lane;
      int cB[4];
#pragma unroll
      for (int nt = 0; nt < 4; ++nt) cB[nt] = (32 * nt + r32) * CHS + hi * 16;
#pragma unroll
      for (int ks = 0; ks < 32; ++ks) { const bf16x8 afr = fr3[ks * 64]; const int base = (ks < 16 ? L_XZ : L_U) + (ks & 15) * 32;
#pragma unroll
          for (int nt = 0; nt < 4; ++nt) { const bf16x8 bfr = *(LAS const bf16x8*)(lds + base + cB[nt]); acc[nt] = __builtin_amdgcn_mfma_f32_32x32x16_bf16(afr, bfr, acc[nt], 0, 0, 0); } } }
#pragma unroll
    for (int nt = 0; nt < 4; ++nt)
#pragma unroll
        for (int rq = 0; rq < 4; ++rq) { const int t = 2 * w + (rq >> 1), c0 = 8 * (rq & 1) + 4 * hi; const size_t s = (size_t)(32 * nt + r32) * 16 + t;
            float y_[4];
#pragma unroll
            for (int e = 0; e < 4; ++e) y_[e] = fminf(fmaxf(gelu_erf(acc[nt][4 * rq + e]) * Y8_SCALE, -448.f), 448.f);
            int q = 0; q = __builtin_amdgcn_cvt_pk_fp8_f32(y_[0], y_[1], q, false); q = __builtin_amdgcn_cvt_pk_fp8_f32(y_[2], y_[3], q, true);
            *(unsigned*)((unsigned char*)YA + ((size_t)(b * 64 + g) * SEQ + s) * 16 + c0) = (unsigned)q; }
    LDS_WAIT(); __syncthreads();
}
}
__device__ __forceinline__ void ssm_mfma_phase(Frame& F) {
    for (int c = F.vcu; c < BATCH * SSM_G / 4; c += F.G)
        for (int u = 4 * c; u < 4 * c + 4; ++u) ssm::unit(F, u & 15, u >> 4);
}

namespace att {
using bf16x8 = __attribute__((ext_vector_type(8))) short;
using s16x4  = __attribute__((ext_vector_type(4))) short;
using f32x16 = __attribute__((ext_vector_type(16))) float;
using u32x4  = __attribute__((ext_vector_type(4))) unsigned;
constexpr int KVB = 64, SHM_V = KVB * 128 * 2, SHM_K = KVB * 128 * 2;
constexpr int L_V = 0, L_K = 2 * SHM_V, L_WS = 2 * SHM_V + 2 * SHM_K;
#define KSWZ(row, colB) ((row) * 256 + ((colB) ^ (((row) & 7) << 4)))
#define SBAR() __builtin_amdgcn_sched_barrier(0)
__device__ __forceinline__ int crow(int r, int hi) { return (r & 3) + 8 * (r >> 2) + 4 * hi; }
__device__ __forceinline__ int v_st(int k, int c) { const int kk = (k & ~0xC) | ((k & 4) << 1) | ((k & 8) >> 1); return ((kk >> 3) * 4 + (c >> 5)) * 512 + ((kk & 7) * 32 + (c & 31)) * 2; }
__device__ __forceinline__ int v_rd_base(int lane) { return ((lane & 3) << 3) | (((lane >> 2) & 3) << 6) | (((lane >> 4) & 1) << 5) | (((lane >> 5) & 1) << 8); }
constexpr int v_rd_off(int d0, int ks, int half) { return d0 * 512 + ks * 4096 + half * 2048; }
template <int OFF> __device__ __forceinline__ s16x4 tr_read(int vb) { s16x4 r; asm volatile("ds_read_b64_tr_b16 %0, %1 offset:%2" : "=&v"(r) : "v"(vb), "i"(OFF) : "memory"); return r; }
template <int D0> __device__ __forceinline__ void pv_one(f32x16& od, int vb, bf16x8 pa0, bf16x8 pa1, bf16x8 pa2, bf16x8 pa3) {
    const s16x4 l0 = tr_read<v_rd_off(D0, 0, 0)>(vb), h0 = tr_read<v_rd_off(D0, 0, 1)>(vb), l1 = tr_read<v_rd_off(D0, 1, 0)>(vb), h1 = tr_read<v_rd_off(D0, 1, 1)>(vb);
    const s16x4 l2 = tr_read<v_rd_off(D0, 2, 0)>(vb), h2 = tr_read<v_rd_off(D0, 2, 1)>(vb), l3 = tr_read<v_rd_off(D0, 3, 0)>(vb), h3 = tr_read<v_rd_off(D0, 3, 1)>(vb);
    asm volatile("s_waitcnt lgkmcnt(0)" ::: "memory"); SBAR();
#define PK(L, H) (bf16x8){L[0], L[1], L[2], L[3], H[0], H[1], H[2], H[3]}
    od = __builtin_amdgcn_mfma_f32_32x32x16_bf16(pa0, PK(l0, h0), od, 0, 0, 0);
    od = __builtin_amdgcn_mfma_f32_32x32x16_bf16(pa1, PK(l1, h1), od, 0, 0, 0);
    od = __builtin_amdgcn_mfma_f32_32x32x16_bf16(pa2, PK(l2, h2), od, 0, 0, 0);
    od = __builtin_amdgcn_mfma_f32_32x32x16_bf16(pa3, PK(l3, h3), od, 0, 0, 0);
#undef PK
}
template <int D0> __device__ __forceinline__ void pv_reads(s16x4 (&l)[4], s16x4 (&h)[4], int vb) {
    l[0] = tr_read<v_rd_off(D0, 0, 0)>(vb); h[0] = tr_read<v_rd_off(D0, 0, 1)>(vb); l[1] = tr_read<v_rd_off(D0, 1, 0)>(vb); h[1] = tr_read<v_rd_off(D0, 1, 1)>(vb);
    l[2] = tr_read<v_rd_off(D0, 2, 0)>(vb); h[2] = tr_read<v_rd_off(D0, 2, 1)>(vb); l[3] = tr_read<v_rd_off(D0, 3, 0)>(vb); h[3] = tr_read<v_rd_off(D0, 3, 1)>(vb);
}
__device__ __forceinline__ void pv_mma(f32x16& od, const s16x4 (&l)[4], const s16x4 (&h)[4], bf16x8 pa0, bf16x8 pa1, bf16x8 pa2, bf16x8 pa3) {
#define PK(L, H) (bf16x8){L[0], L[1], L[2], L[3], H[0], H[1], H[2], H[3]}
    od = __builtin_amdgcn_mfma_f32_32x32x16_bf16(pa0, PK(l[0], h[0]), od, 0, 0, 0);
    od = __builtin_amdgcn_mfma_f32_32x32x16_bf16(pa1, PK(l[1], h[1]), od, 0, 0, 0);
    od = __builtin_amdgcn_mfma_f32_32x32x16_bf16(pa2, PK(l[2], h[2]), od, 0, 0, 0);
    od = __builtin_amdgcn_mfma_f32_32x32x16_bf16(pa3, PK(l[3], h[3]), od, 0, 0, 0);
#undef PK
}
__device__ __forceinline__ void pv_all(f32x16 (&o)[4], int vb, bf16x8 pa0, bf16x8 pa1, bf16x8 pa2, bf16x8 pa3) {
    s16x4 la[4], ha[4], lb[4], hb[4];
    asm volatile("s_waitcnt lgkmcnt(0)" ::: "memory"); SBAR();
    pv_reads<0>(la, ha, vb);
    pv_reads<1>(lb, hb, vb); asm volatile("s_waitcnt lgkmcnt(8)" ::: "memory"); SBAR(); pv_mma(o[0], la, ha, pa0, pa1, pa2, pa3); SBAR();
    pv_reads<2>(la, ha, vb); asm volatile("s_waitcnt lgkmcnt(8)" ::: "memory"); SBAR(); pv_mma(o[1], lb, hb, pa0, pa1, pa2, pa3); SBAR();
    pv_reads<3>(lb, hb, vb); asm volatile("s_waitcnt lgkmcnt(8)" ::: "memory"); SBAR(); pv_mma(o[2], la, ha, pa0, pa1, pa2, pa3); SBAR();
    asm volatile("s_waitcnt lgkmcnt(0)" ::: "memory"); SBAR(); pv_mma(o[3], lb, hb, pa0, pa1, pa2, pa3);
}
__device__ __forceinline__ void qkt(f32x16& p0, f32x16& p1, LAS const char* Ks, const bf16x8* qr, int r32, int hi) {
    p0 = f32x16{}; p1 = f32x16{};
#pragma unroll
    for (int d0 = 0; d0 < 8; ++d0) { const int cb = (d0 * 16 + hi * 8) * 2;
        const bf16x8 b0 = *(LAS const bf16x8*)(Ks + KSWZ(r32, cb));
        const bf16x8 b1 = *(LAS const bf16x8*)(Ks + KSWZ(32 + r32, cb));
        p0 = __builtin_amdgcn_mfma_f32_32x32x16_bf16(b0, qr[d0], p0, 0, 0, 0);
        p1 = __builtin_amdgcn_mfma_f32_32x32x16_bf16(b1, qr[d0], p1, 0, 0, 0); }
}
__device__ __forceinline__ float sum16(float d) {
    d += __builtin_bit_cast(float, __builtin_amdgcn_update_dpp(0, __builtin_bit_cast(int, d), 0xB1, 0xF, 0xF, true));
    d += __builtin_bit_cast(float, __builtin_amdgcn_update_dpp(0, __builtin_bit_cast(int, d), 0x4E, 0xF, 0xF, true));
    d += __builtin_bit_cast(float, __builtin_amdgcn_update_dpp(0, __builtin_bit_cast(int, d), 0x141, 0xF, 0xF, true));
    d += __builtin_bit_cast(float, __builtin_amdgcn_update_dpp(0, __builtin_bit_cast(int, d), 0x140, 0xF, 0xF, true));
    return d;
}
constexpr float THR2 = 8.f;
__device__ __forceinline__ void attn_unit(Frame& F, int b, int kvh, int qb, int hp) {
    const int tid = F.tid, wid = F.wave, lane = F.lane, r32 = lane & 31, hi = lane >> 5, wq = wid & 3, h = kvh * 4 + 2 * hp + (wid >> 2);
    LAS char* lds = (LAS char*)F.lds;
    LAS float* wsf = (LAS float*)(lds + L_WS) + wid * 64; LAS float* li_l = wsf; LAS float* al_l = wsf + 32;
    const bf16* Q = (const bf16*)(F.ws + WS_Q); const bf16* KVp = (const bf16*)(F.ws + WS_KV); bf16* O = (bf16*)(F.ws + WS_BUFA);
    const int q0 = qb * 128, kbase = q0 - 128, jlo = (qb == 0) ? 2 : 0, jhi = (qb == 15) ? 4 : 6;
    const size_t rowb = (size_t)b * SEQ;
    bf16x8 qr[8];
    { const bf16* Qw = Q + (rowb + q0 + wq * 32 + r32) * 2048 + h * 128 + hi * 8; v4u raw[8]; float ss = 0.f;
#pragma unroll
      for (int d0 = 0; d0 < 8; ++d0) { raw[d0] = *(const v4u*)(Qw + d0 * 16);
          const float a0 = bflo(raw[d0].x), a1 = bfhi(raw[d0].x), a2 = bflo(raw[d0].y), a3 = bfhi(raw[d0].y), a4 = bflo(raw[d0].z), a5 = bfhi(raw[d0].z), a6 = bflo(raw[d0].w), a7 = bfhi(raw[d0].w);
          ss += (a0 * a0 + a1 * a1) + (a2 * a2 + a3 * a3) + (a4 * a4 + a5 * a5) + (a6 * a6 + a7 * a7); }
      { auto rr = __builtin_amdgcn_permlane32_swap(__float_as_uint(ss), __float_as_uint(ss), false, false); ss = __uint_as_float(rr[0]) + __uint_as_float(rr[1]); }
      const float rs = (1.0f / sqrtf(ss * (1.f / 128.f) + RMS_EPS)) * (0.08838834764831845f * 1.4426950408889634f);
#pragma unroll
      for (int d0 = 0; d0 < 8; ++d0) { const f32x4 g0 = *(const f32x4*)(F.in[IN_QG] + d0 * 16 + hi * 8), g1 = *(const f32x4*)(F.in[IN_QG] + d0 * 16 + hi * 8 + 4);
          u32x4 w; w.x = pk2(bflo(raw[d0].x) * rs * g0.x, bfhi(raw[d0].x) * rs * g0.y); w.y = pk2(bflo(raw[d0].y) * rs * g0.z, bfhi(raw[d0].y) * rs * g0.w);
          w.z = pk2(bflo(raw[d0].z) * rs * g1.x, bfhi(raw[d0].z) * rs * g1.y); w.w = pk2(bflo(raw[d0].w) * rs * g1.z, bfhi(raw[d0].w) * rs * g1.w);
          qr[d0] = __builtin_bit_cast(bf16x8, w); } }
    const int sr = tid >> 4, sc = (tid & 15) * 8, vst0 = v_st(sr, sc), vst1 = v_st(32 + sr, sc);
    const f32x4 gk0 = *(const f32x4*)(F.in[IN_KG] + sc), gk1 = *(const f32x4*)(F.in[IN_KG] + sc + 4);
    const int vb0 = (int)(uintptr_t)(lds + L_V) + v_rd_base(lane);
    v4u sv0, sv1, sk0, sk1;
#define SLOAD(j) do { const bf16* kp_ = KVp + (rowb + kbase + (j) * 64 + sr) * 1024 + kvh * 128 + sc; \
        sk0 = *(const v4u*)kp_; sk1 = *(const v4u*)(kp_ + 32 * 1024); sv0 = *(const v4u*)(kp_ + 512); sv1 = *(const v4u*)(kp_ + 32 * 1024 + 512); } while (0)
#define KNORM(kk) do { const float a0 = bflo(kk.x), a1 = bfhi(kk.x), a2 = bflo(kk.y), a3 = bfhi(kk.y), a4 = bflo(kk.z), a5 = bfhi(kk.z), a6 = bflo(kk.w), a7 = bfhi(kk.w); \
        const float ss_ = sum16((a0 * a0 + a1 * a1) + (a2 * a2 + a3 * a3) + (a4 * a4 + a5 * a5) + (a6 * a6 + a7 * a7)); const float rk_ = 1.0f / sqrtf(ss_ * (1.f / 128.f) + RMS_EPS); \
        kk.x = pk2(a0 * rk_ * gk0.x, a1 * rk_ * gk0.y); kk.y = pk2(a2 * rk_ * gk0.z, a3 * rk_ * gk0.w); kk.z = pk2(a4 * rk_ * gk1.x, a5 * rk_ * gk1.y); kk.w = pk2(a6 * rk_ * gk1.z, a7 * rk_ * gk1.w); } while (0)
#define SWRITE(bf) do { KNORM(sk0); KNORM(sk1); *(LAS v4u*)(lds + L_V + (bf) * SHM_V + vst0) = sv0; *(LAS v4u*)(lds + L_V + (bf) * SHM_V + vst1) = sv1; \
        *(LAS v4u*)(lds + L_K + (bf) * SHM_K + KSWZ(sr, sc * 2)) = sk0; *(LAS v4u*)(lds + L_K + (bf) * SHM_K + KSWZ(32 + sr, sc * 2)) = sk1; } while (0)
    const float LOG2E = 1.4426950408889634f;
    const float slope2 = exp2f(-0.5f * (float)(h + 1)) * LOG2E;
    float m_reg = F.in[IN_SINK][h] * LOG2E, l_reg = 1.f; f32x16 o[4] = {};
    const int q_rel = 128 + wq * 32 + r32, wlo = wq >> 1, whi = (wq >> 1) + 4;
    SLOAD(jlo); SWRITE(0); __syncthreads();
    for (int j = jlo; j < jhi; ++j) {
        const int bf = (j - jlo) & 1;
        if (j + 1 < jhi) SLOAD(j + 1);
        if (j >= wlo && j <= whi) {
            f32x16 p0, p1; qkt(p0, p1, lds + L_K + bf * SHM_K, qr, r32, hi);
            const int kt0 = 64 * j + 4 * hi;
#pragma unroll
            for (int r = 0; r < 16; ++r) { const int k0 = kt0 + (r & 3) + 8 * (r >> 2); int d0 = q_rel - k0; d0 = d0 < 0 ? -d0 : d0; int d1 = q_rel - k0 - 32; d1 = d1 < 0 ? -d1 : d1;
                p0[r] = (d0 <= WINDOW) ? p0[r] - slope2 * (float)d0 : -1e30f; p1[r] = (d1 <= WINDOW) ? p1[r] - slope2 * (float)d1 : -1e30f; }
            float pmax = p0[0];
#pragma unroll
            for (int r = 1; r < 16; ++r) pmax = fmaxf(pmax, p0[r]);
#pragma unroll
            for (int r = 0; r < 16; ++r) pmax = fmaxf(pmax, p1[r]);
            { auto rr = __builtin_amdgcn_permlane32_swap(__float_as_uint(pmax), __float_as_uint(pmax), false, false); pmax = fmaxf(__uint_as_float(rr[0]), __uint_as_float(rr[1])); }
            float alpha = 1.f;
            if (!__all(pmax - m_reg <= THR2)) { const float mn = fmaxf(m_reg, pmax); alpha = __builtin_amdgcn_exp2f(m_reg - mn); m_reg = mn; }
#pragma unroll
            for (int r = 0; r < 16; ++r) { p0[r] = __builtin_amdgcn_exp2f(p0[r] - m_reg); p1[r] = __builtin_amdgcn_exp2f(p1[r] - m_reg); }
            float ps = 0.f;
#pragma unroll
            for (int r = 0; r < 16; ++r) ps += p0[r] + p1[r];
            { auto rr = __builtin_amdgcn_permlane32_swap(__float_as_uint(ps), __float_as_uint(ps), false, false); ps = __uint_as_float(rr[0]) + __uint_as_float(rr[1]); }
            l_reg = l_reg * alpha + ps;
            bf16x8 pa0, pa1, pa2, pa3;
#define PK4(P, BASE, OUT) do { const unsigned a0_ = pk2(P[BASE + 0], P[BASE + 1]), a1_ = pk2(P[BASE + 2], P[BASE + 3]), b0_ = pk2(P[BASE + 4], P[BASE + 5]), b1_ = pk2(P[BASE + 6], P[BASE + 7]); \
        auto r0_ = __builtin_amdgcn_permlane32_swap(a0_, b0_, false, false); auto r1_ = __builtin_amdgcn_permlane32_swap(a1_, b1_, false, false); \
        u32x4 w_ = {r0_[0], r1_[0], r0_[1], r1_[1]}; OUT = __builtin_bit_cast(bf16x8, w_); } while (0)
            PK4(p0, 0, pa0); PK4(p0, 8, pa1); PK4(p1, 0, pa2); PK4(p1, 8, pa3);
#undef PK4
            if (__any(alpha < 1.f)) { if (hi == 0) al_l[r32] = alpha; asm volatile("s_waitcnt lgkmcnt(0)" ::: "memory");
#pragma unroll
                for (int d = 0; d < 4; ++d)
#pragma unroll
                    for (int r = 0; r < 16; ++r) o[d][r] *= al_l[crow(r, hi)]; }
            const int vb = vb0 + bf * SHM_V;
            pv_all(o, vb, pa0, pa1, pa2, pa3);
        }
        if (j + 1 < jhi) SWRITE(bf ^ 1);
        __syncthreads();
    }
    if (hi == 0) li_l[r32] = l_reg; asm volatile("s_waitcnt lgkmcnt(0)" ::: "memory");
    float rli[16];
#pragma unroll
    for (int r = 0; r < 16; ++r) rli[r] = __builtin_amdgcn_rcpf(li_l[crow(r, hi)]);
    LAS unsigned char* stg = (LAS unsigned char*)(lds + wid * 4096);
#pragma unroll
    for (int r = 0; r < 16; ++r) { const int orow = crow(r, hi); const float sc_ = rli[r] * O8_SCALE;
#pragma unroll
        for (int d0 = 0; d0 < 4; d0 += 2) { const float v0 = fminf(fmaxf(o[d0][r] * sc_, -448.f), 448.f), v1 = fminf(fmaxf(o[d0 + 1][r] * sc_, -448.f), 448.f);
            const int q = __builtin_amdgcn_cvt_pk_fp8_f32(v0, v1, 0, false);
            stg[orow * 128 + d0 * 32 + r32] = (unsigned char)(q & 0xff); stg[orow * 128 + (d0 + 1) * 32 + r32] = (unsigned char)((q >> 8) & 0xff); } }
    asm volatile("s_waitcnt lgkmcnt(0)" ::: "memory");
    unsigned char* Ow = (unsigned char*)O + (rowb + q0 + wq * 32) * 2048 + h * 128;
#pragma unroll
    for (int i = 0; i < 4; ++i) { const int row = i * 8 + (lane >> 3), ch = lane & 7; const v4u v = *(LAS const v4u*)(stg + row * 128 + ch * 16); *(v4u*)(Ow + (size_t)row * 2048 + ch * 16) = v; }
    asm volatile("s_waitcnt lgkmcnt(0)" ::: "memory"); __syncthreads();
#undef SLOAD
#undef KNORM
#undef SWRITE
}
#undef KSWZ
#undef SBAR
}
__device__ __forceinline__ void attn_flash_phase(Frame& F) {
    const int NU = BATCH * NKVH * (SEQ / 128) * 2;
    for (int c = F.vcu; c < NU / 8; c += F.G)
        for (int u = 8 * c; u < 8 * c + 8; ++u) {
            const int hp = u & 1, qb = (u >> 1) & 15, kvh = (u >> 5) & 3, b = u >> 7;
            att::attn_unit(F, b, kvh, qb, hp);
        }
}

constexpr size_t WS_T8D = WS_DOWNB, WS_T8U = WS_DOWNB + 32 * MiB, WS_SCD = 142 * MiB, WS_SCU = 142 * MiB + 65536;
__device__ __forceinline__ int pack_i8x4(float a, float b, float c, float d) {
    const int ia = (int)__builtin_rintf(a), ib = (int)__builtin_rintf(b), ic = (int)__builtin_rintf(c), id = (int)__builtin_rintf(d);
    return (ia & 0xff) | ((ib & 0xff) << 8) | ((ic & 0xff) << 16) | (id << 24);
}
__device__ __forceinline__ void peer_tables_phase(Frame& F) {
    const int gw = F.vcu * NWAVES + F.wave, NGW = F.G * NWAVES, lane = F.lane;
    const f32x4* G4 = (const f32x4*)F.in[IN_FFNG];
    for (int r = gw; r < 2 * NEXP; r += NGW) {
        const int tbl = r >= NEXP, e = r - tbl * NEXP;
        const f32x4* srcp = (const f32x4*)(F.in[tbl ? IN_PUP : IN_PDOWN]) + (size_t)e * 512;
        f32x4 v[8]; float amax = 0.f;
#pragma unroll
        for (int jj = 0; jj < 8; ++jj) { v[jj] = __builtin_nontemporal_load(srcp + lane + 64 * jj); if (!tbl) v[jj] = v[jj] * G4[lane + 64 * jj];
            amax = fmaxf(amax, fmaxf(fmaxf(fabsf(v[jj].x), fabsf(v[jj].y)), fmaxf(fabsf(v[jj].z), fabsf(v[jj].w)))); }
        amax = wave_max(amax);
        const float qmax = 127.f;
        const float inv = amax > 0.f ? qmax / amax : 0.f;
        if (lane == 0) ((float*)(F.ws + (tbl ? WS_SCU : WS_SCD)))[e] = amax / qmax;
        unsigned char* T8 = F.ws + (tbl ? WS_T8U : WS_T8D);
#pragma unroll
        for (int jj = 0; jj < 8; ++jj) { int q = 0;
            q = pack_i8x4(v[jj].x * inv, v[jj].y * inv, v[jj].z * inv, v[jj].w * inv);
            const int col = 256 * jj + 4 * lane;
            *(unsigned*)(T8 + ((size_t)(col >> 7) * NEXP + e) * 128 + (col & 127)) = (unsigned)q; }
    }
}

namespace pks {
using bf16x8 = __attribute__((ext_vector_type(8))) short;
using f32x16 = __attribute__((ext_vector_type(16))) float;
#define KSWZ(row, colB) ((row) * 256 + ((colB) ^ (((row) & 7) << 4)))
__device__ __forceinline__ int f2ord(float f) { const int s = __float_as_int(f); return s ^ ((s >> 31) & 0x7fffffff); }
__device__ __forceinline__ float ord2f(int s) { return __int_as_float(s ^ ((s >> 31) & 0x7fffffff)); }
__device__ __forceinline__ int imax(int a, int b) { return a > b ? a : b; }
__device__ __forceinline__ int imin(int a, int b) { return a < b ? a : b; }
__device__ __forceinline__ void merge16(int (&a)[16]) {
#pragma unroll
    for (int j = 8; j > 0; j >>= 1)
#pragma unroll
        for (int i = 0; i < 16; ++i) { const int l = i ^ j; if (l > i) { const int hi_ = imax(a[i], a[l]), lo_ = imin(a[i], a[l]); a[i] = hi_; a[l] = lo_; } }
}
__device__ __forceinline__ void sort16(int (&a)[16]) {
#pragma unroll
    for (int k = 2; k <= 16; k <<= 1)
#pragma unroll
        for (int j = k >> 1; j > 0; j >>= 1)
#pragma unroll
            for (int i = 0; i < 16; ++i) { const int l = i ^ j; if (l > i) { const int hi_ = imax(a[i], a[l]), lo_ = imin(a[i], a[l]); if ((i & k) == 0) { a[i] = hi_; a[l] = lo_; } else { a[i] = lo_; a[l] = hi_; } } }
}
__device__ __forceinline__ void top16(int (&a)[16], const int (&b)[16]) {
#pragma unroll
    for (int i = 0; i < 16; ++i) a[i] = imax(a[i], b[15 - i]);
    merge16(a);
}
__device__ __forceinline__ int crow(int r, int hi) { return (r & 3) + 8 * (r >> 2) + 4 * hi; }
__device__ __forceinline__ void stage_keys(Frame& F, int hd) {
    LAS char* lds = (LAS char*)F.lds;
#pragma unroll
    for (int i = 0; i < 8; ++i) { const int pc = F.tid + 512 * i, half = pc >> 11, row = (pc >> 4) & 127, ch = pc & 15;
        const float* src = F.in[half ? IN_SK2 : IN_SK1] + ((size_t)hd * 128 + row) * 128 + ch * 8;
        const f32x4 a = *(const f32x4*)src, b = *(const f32x4*)(src + 4);
        v4u w; w.x = pk2(a.x, a.y); w.y = pk2(a.z, a.w); w.z = pk2(b.x, b.y); w.w = pk2(b.z, b.w);
        *(LAS v4u*)(lds + half * 32768 + KSWZ(row, ch * 16)) = w; }
    LDS_WAIT(); __syncthreads();
}
__device__ __forceinline__ void unit(Frame& F, int tile, int hd) {
    const int tid = F.tid, wid = F.wave, lane = F.lane, r32 = lane & 31, hi = lane >> 5;
    LAS char* lds = (LAS char*)F.lds; LAS int* SCR = (LAS int*)(lds + 65536);
    const bf16* QP = (const bf16*)(F.ws + WS_BUFA); const float* SSQ = (const float*)(F.ws + WS_SSQ);
    int* IDX = (int*)(F.ws + WS_IDX); float* GATE = (float*)(F.ws + WS_GATE);
    const int t = tile * 256 + wid * 32 + r32;
    float rs2;
    { const f32x4* sp = (const f32x4*)(SSQ + (size_t)t * 32); float s = 0.f;
#pragma unroll
      for (int i = 0; i < 8; ++i) { const f32x4 v = sp[i]; s += (v.x + v.y) + (v.z + v.w); }
      rs2 = 1.0f / sqrtf(s * (1.f / D_MODEL) + RMS_EPS); }
    int T[2][16];
#pragma unroll
    for (int half = 0; half < 2; ++half) {
        bf16x8 qf[8];
        { const bf16* qp = QP + (size_t)t * 2048 + hd * 256 + half * 128 + hi * 8;
#pragma unroll
          for (int d0 = 0; d0 < 8; ++d0) qf[d0] = *(const bf16x8*)(qp + d0 * 16); }
        f32x16 p[4] = {};
        LAS const char* Ks = lds + half * 32768;
#pragma unroll
        for (int d0 = 0; d0 < 8; ++d0) { const int cb = (d0 * 16 + hi * 8) * 2;
#pragma unroll
            for (int kt = 0; kt < 4; ++kt) { const bf16x8 kf = *(LAS const bf16x8*)(Ks + KSWZ(32 * kt + r32, cb)); p[kt] = __builtin_amdgcn_mfma_f32_32x32x16_bf16(kf, qf[d0], p[kt], 0, 0, 0); } }
        int g[4][16];
#pragma unroll
        for (int kt = 0; kt < 4; ++kt)
#pragma unroll
            for (int r = 0; r < 16; ++r) g[kt][r] = (f2ord(p[kt][r]) & ~127) | (127 - (32 * kt + crow(r, hi)));
        sort16(g[0]); sort16(g[1]); sort16(g[2]); sort16(g[3]);
        top16(g[0], g[1]); top16(g[2], g[3]); top16(g[0], g[2]);
        int pr[16];
#pragma unroll
        for (int i = 0; i < 16; ++i) pr[i] = __shfl_xor(g[0][i], 32);
        top16(g[0], pr);
#pragma unroll
        for (int i = 0; i < 16; ++i) { T[half][i] = g[0][i]; SCR[(16 * half + i) * 512 + tid] = 127 - (g[0][i] & 127); }
    }
    float v1[16], v2[16];
#pragma unroll
    for (int i = 0; i < 16; ++i) { v1[i] = ord2f(T[0][i] & ~127); v2[i] = ord2f(T[1][i] & ~127); }
#define CAND(i, j) ((f2ord(v1[i] + v2[j]) & ~255) | (255 - (16 * (i) + (j))))
    const int NEGK = (int)0x80000000;
    int G0[16], G1[16], G2[16], G3[16];
#pragma unroll
    for (int j = 0; j < 16; ++j) G0[j] = CAND(0, j);
#pragma unroll
    for (int j = 0; j < 8; ++j) { G1[j] = CAND(1, j); G1[15 - j] = CAND(8 + j, 0); }
    G2[0] = CAND(2, 0); G2[1] = CAND(2, 1); G2[2] = CAND(2, 2); G2[3] = CAND(2, 3); G2[4] = CAND(2, 4);
    G2[5] = CAND(3, 0); G2[6] = CAND(3, 1); G2[7] = CAND(3, 2); G2[8] = CAND(3, 3);
    G2[9] = CAND(4, 0); G2[10] = CAND(4, 1); G2[11] = CAND(4, 2);
    G2[12] = CAND(5, 0); G2[13] = CAND(5, 1); G2[14] = CAND(6, 0); G2[15] = CAND(6, 1);
    G3[0] = CAND(7, 0); G3[1] = CAND(7, 1);
#pragma unroll
    for (int j = 2; j < 16; ++j) G3[j] = NEGK;
#undef CAND
    merge16(G1); sort16(G2);
    top16(G0, G1); top16(G2, G3); top16(G0, G2);
    float e[16], den = 0.f; const float vmax = ord2f(G0[0] & ~255);
#pragma unroll
    for (int r = 0; r < 16; ++r) { e[r] = __expf(rs2 * (ord2f(G0[r] & ~255) - vmax)); den += e[r]; }
    const float inv = 1.0f / den;
    LDS_WAIT(); asm volatile("" ::: "memory");
    int oi[8]; float og[8];
#pragma unroll
    for (int rr = 0; rr < 8; ++rr) { const int key = hi ? G0[8 + rr] : G0[rr]; const int code = 255 - (key & 255);
        oi[rr] = SCR[(code >> 4) * 512 + tid] * NKEYS + SCR[(16 + (code & 15)) * 512 + tid]; og[rr] = (hi ? e[8 + rr] : e[rr]) * inv; }
    int* ip = IDX + (size_t)t * KSEL + hd * 16 + hi * 8; float* gp = GATE + (size_t)t * KSEL + hd * 16 + hi * 8;
    *(v4u*)ip = v4u{(unsigned)oi[0], (unsigned)oi[1], (unsigned)oi[2], (unsigned)oi[3]}; *(v4u*)(ip + 4) = v4u{(unsigned)oi[4], (unsigned)oi[5], (unsigned)oi[6], (unsigned)oi[7]};
    *(f32x4*)gp = f32x4{og[0], og[1], og[2], og[3]}; *(f32x4*)(gp + 4) = f32x4{og[4], og[5], og[6], og[7]};
    LDS_WAIT(); asm volatile("" ::: "memory");
}
#undef KSWZ
}
__device__ __forceinline__ void peer_score_mfma_phase(Frame& F) {
    int staged = -1;
    for (int u = F.vcu; u < (T_TOK / 256) * PEER_H; u += F.G) {
        const int hd = u & 7, tile = u >> 3;
        if (hd != staged) { __syncthreads(); pks::stage_keys(F, hd); staged = hd; }
        pks::unit(F, tile, hd);
    }
    __syncthreads();
}

typedef __bf16 bf16x2v __attribute__((ext_vector_type(2)));
#define BF2(x) __builtin_bit_cast(bf16x2v, (unsigned)(x))
__device__ __forceinline__ float dot8_bf(v4u a, v4u b) {
    float d = __builtin_amdgcn_fdot2_f32_bf16(BF2(a.x), BF2(b.x), 0.f, false);
    d = __builtin_amdgcn_fdot2_f32_bf16(BF2(a.y), BF2(b.y), d, false);
    d = __builtin_amdgcn_fdot2_f32_bf16(BF2(a.z), BF2(b.z), d, false);
    return __builtin_amdgcn_fdot2_f32_bf16(BF2(a.w), BF2(b.w), d, false);
}
__device__ __forceinline__ float dpp_sum8(float d) {
    d += __builtin_bit_cast(float, __builtin_amdgcn_update_dpp(0, __builtin_bit_cast(int, d), 0xB1, 0xF, 0xF, true));
    d += __builtin_bit_cast(float, __builtin_amdgcn_update_dpp(0, __builtin_bit_cast(int, d), 0x4E, 0xF, 0xF, true));
    d += __builtin_bit_cast(float, __builtin_amdgcn_update_dpp(0, __builtin_bit_cast(int, d), 0x141, 0xF, 0xF, true));
    return d;
}
#ifndef MK_XMODE
#define MK_XMODE 1
#endif
#ifndef GATHER_AUX
#define GATHER_AUX 16
#endif
#ifndef MK_ALIGN_EVERY
#define MK_ALIGN_EVERY 16
#endif
#define DPPF(x, ctrl) __builtin_bit_cast(float, __builtin_amdgcn_update_dpp(0, __builtin_bit_cast(int, (float)(x)), ctrl, 0xF, 0xF, true))
constexpr size_t WS_X8 = WS_Q;
#define DPPI(x, ctrl) __builtin_amdgcn_update_dpp(0, (int)(x), ctrl, 0xF, 0xF, true)
__device__ __forceinline__ void peer_expert_sliced_phase(Frame& F, const XcdBarrier& bar, const bool dostore) {
    const int xmode = dostore ? 1 : MK_XMODE;
    const int lane = F.lane, j = lane >> 3, sub = lane & 7;
    LAS unsigned* IDXL = (LAS unsigned*)(F.lds + F.wave * 16384); LAS float* ACTL = (LAS float*)(F.lds + F.wave * 16384 + 8192); LAS int* ACTI = (LAS int*)ACTL;
    LAS float* XSC = (LAS float*)(F.lds + 131072 + F.wave * 64); LAS float* WSC = (LAS float*)(F.lds + 131072 + 512 + F.wave * 64); LAS signed char* W8L = (LAS signed char*)(F.lds + 131072 + 1024 + F.wave * 2048);
    const bf16* XB = (const bf16*)(F.ws + WS_BUFB); const float* SSQ = (const float*)(F.ws + WS_SSQ);
    const int* IDX = (const int*)(F.ws + WS_IDX); const float* GATE = (const float*)(F.ws + WS_GATE);
    const unsigned char* DBb = F.ws + WS_T8D; const unsigned char* UBb = F.ws + WS_T8U; unsigned char* X8 = F.ws + WS_X8;
    const __amdgpu_buffer_rsrc_t rsD = __builtin_amdgcn_make_buffer_rsrc((void*)DBb, 0, 32 << 20, 0x00020000), rsU = __builtin_amdgcn_make_buffer_rsrc((void*)UBb, 0, 32 << 20, 0x00020000);
    const __amdgpu_buffer_rsrc_t rsX = __builtin_amdgcn_make_buffer_rsrc((void*)X8, 0, 64 << 20, 0x00020000);
    const float* SCD = (const float*)(F.ws + WS_SCD); const float* SCU = (const float*)(F.ws + WS_SCU);
    struct DBuf { v4u pc[16]; v4u x; };
    struct UBuf { v4u pc[16]; };
    constexpr int NIT = 16 * 16;
    for (int chunk = F.vcu; chunk < T_TOK / 128; chunk += F.G) {
        const int t0 = chunk * 128 + F.wave * 16;
        for (int tok = 0; tok < 16; ++tok) {
#pragma unroll
            for (int a = 0; a < 2; ++a) { IDXL[tok * 128 + 64 * a + lane] = (unsigned)(xmode == 2 ? (IDX[(size_t)(t0 + tok) * KSEL + 64 * a + lane] & 63) : IDX[(size_t)(t0 + tok) * KSEL + 64 * a + lane]) * 128u; ACTI[tok * 128 + 64 * a + lane] = 0; }
            const v4u* xr = (const v4u*)(XB + (size_t)(t0 + tok) * 2048 + 32 * lane); v4u w[4]; float amax = 0.f;
#pragma unroll
            for (int k = 0; k < 4; ++k) { w[k] = xr[k];
#pragma unroll
                for (int c = 0; c < 4; ++c) amax = fmaxf(amax, fmaxf(fabsf(bflo(w[k][c])), fabsf(bfhi(w[k][c])))); }
            amax = wave_max(amax); const float inv = amax > 0.f ? 127.f / amax : 0.f;
            if (lane == 0) XSC[tok] = amax * (1.f / 127.f);
            unsigned q8[8];
#pragma unroll
            for (int d = 0; d < 8; ++d) { const unsigned wa = w[d >> 1][2 * (d & 1)], wb = w[d >> 1][2 * (d & 1) + 1]; q8[d] = (unsigned)pack_i8x4(bflo(wa) * inv, bfhi(wa) * inv, bflo(wb) * inv, bfhi(wb) * inv); }
            unsigned char* xo = X8 + (size_t)(t0 + tok) * 2048 + 32 * lane;
            *(v4u*)xo = v4u{q8[0], q8[1], q8[2], q8[3]}; *(v4u*)(xo + 16) = v4u{q8[4], q8[5], q8[6], q8[7]};
        }
        asm volatile("s_waitcnt vmcnt(0) lgkmcnt(0)" ::: "memory");
        auto dload = [&](DBuf& g, int it) { const int sg = it >> 4, tok = it & 15;
            g.x = __builtin_bit_cast(v4u, __builtin_amdgcn_raw_buffer_load_b128(rsX, (unsigned)((t0 + tok) * 2048 + 128 * sg + 16 * sub), 0, GATHER_AUX));
            const unsigned base = (unsigned)sg * (NEXP * 128) + sub * 16;
#pragma unroll
            for (int a = 0; a < 2; ++a)
#pragma unroll
                for (int i = 0; i < 8; ++i) g.pc[8 * a + i] = __builtin_bit_cast(v4u, __builtin_amdgcn_raw_buffer_load_b128(rsD, base + IDXL[tok * 128 + 64 * a + 8 * j + i], 0, GATHER_AUX)); };
        auto dcomp = [&](DBuf& g, int it) { const int tok = it & 15;
#pragma unroll
            for (int a = 0; a < 2; ++a) { int r[8];
#pragma unroll
                for (int i = 0; i < 8; ++i) { const v4u pc = g.pc[8 * a + i];
                    int acc = __builtin_amdgcn_sdot4((int)pc.x, (int)g.x.x, 0, false); acc = __builtin_amdgcn_sdot4((int)pc.y, (int)g.x.y, acc, false);
                    acc = __builtin_amdgcn_sdot4((int)pc.z, (int)g.x.z, acc, false); r[i] = __builtin_amdgcn_sdot4((int)pc.w, (int)g.x.w, acc, false); }
                int s4[4], s2[2];
#pragma unroll
                for (int i = 0; i < 4; ++i) { const bool up = sub >= 4; const int send = up ? r[i] : r[i + 4], keep = up ? r[i + 4] : r[i]; s4[i] = keep + DPPI(send, 0x141); }
#pragma unroll
                for (int i = 0; i < 2; ++i) { const bool up = (sub & 2) != 0; const int send = up ? s4[i] : s4[i + 2], keep = up ? s4[i + 2] : s4[i]; s2[i] = keep + DPPI(send, 0x4E); }
                { const bool up = (sub & 1) != 0; const int send = up ? s2[0] : s2[1], keep = up ? s2[1] : s2[0]; ACTI[tok * 128 + 64 * a + lane] += keep + DPPI(send, 0xB1); } } };
        { DBuf A, B; dload(A, 0);
          if (xmode != 3) for (int it = 0; it < NIT; it += 2) { if ((it & (16 * MK_ALIGN_EVERY - 1)) == 0) xcd_align(bar); dload(B, it + 1); dcomp(A, it); if (it + 2 < NIT) dload(A, it + 2); dcomp(B, it + 1); } }
        LDS_WAIT(); asm volatile("" ::: "memory");
        for (int tok = 0; tok < 16; ++tok) {
            const float rs2 = XSC[tok] / sqrtf(wave_sum(lane < 32 ? SSQ[(size_t)(t0 + tok) * 32 + lane] : 0.f) * (1.f / D_MODEL) + RMS_EPS);
            float wv[2];
#pragma unroll
            for (int a = 0; a < 2; ++a) { const int p = tok * 128 + 64 * a + lane; const unsigned e = IDXL[p] >> 7;
                wv[a] = GATE[(size_t)(t0 + tok) * KSEL + 64 * a + lane] * gelu_erf((float)ACTI[p] * rs2 * SCD[e]) * SCU[e]; }
            const float wmax = wave_max(fmaxf(fabsf(wv[0]), fabsf(wv[1]))), winv = wmax > 0.f ? 127.f / wmax : 0.f;
            if (lane == 0) WSC[tok] = wmax * (1.f / 127.f);
#pragma unroll
            for (int a = 0; a < 2; ++a) W8L[tok * 128 + 64 * a + lane] = (signed char)(int)__builtin_rintf(wv[a] * winv);
        }
        LDS_WAIT(); asm volatile("" ::: "memory");
        auto uload = [&](UBuf& g, int it) { const int sg = it >> 4, tok = it & 15;
            const unsigned base = (unsigned)sg * (NEXP * 128) + sub * 16;
#pragma unroll
            for (int a = 0; a < 2; ++a)
#pragma unroll
                for (int i = 0; i < 8; ++i) g.pc[8 * a + i] = __builtin_bit_cast(v4u, __builtin_amdgcn_raw_buffer_load_b128(rsU, base + IDXL[tok * 128 + 64 * a + 8 * j + i], 0, GATHER_AUX)); };
        auto ucomp = [&](UBuf& g, int it) { const int sg = it >> 4, tok = it & 15;
            float* op = F.out + (size_t)(t0 + tok) * 2048 + 128 * sg + 16 * sub + 2 * j; const unsigned xw_ = *(const unsigned*)(XB + (size_t)(t0 + tok) * 2048 + 128 * sg + 16 * sub + 2 * j); const f32x2_t x1 = {bflo(xw_), bfhi(xw_)};
            int acc[16];
#pragma unroll
            for (int c = 0; c < 16; ++c) acc[c] = 0;
#pragma unroll
            for (int a = 0; a < 2; ++a) { const v2u wq = *(const LAS v2u*)(W8L + tok * 128 + 64 * a + 8 * j);
#pragma unroll
                for (int h = 0; h < 2; ++h) { const int wd = (int)wq[h];
#pragma unroll
                    for (int d = 0; d < 4; ++d) { const unsigned A_ = g.pc[8 * a + 4 * h][d], B_ = g.pc[8 * a + 4 * h + 1][d], C_ = g.pc[8 * a + 4 * h + 2][d], D_ = g.pc[8 * a + 4 * h + 3][d];
                        const unsigned t0_ = __builtin_amdgcn_perm(B_, A_, 0x05010400u), t1_ = __builtin_amdgcn_perm(B_, A_, 0x07030602u), u0_ = __builtin_amdgcn_perm(D_, C_, 0x05010400u), u1_ = __builtin_amdgcn_perm(D_, C_, 0x07030602u);
                        acc[4 * d + 0] = __builtin_amdgcn_sdot4((int)__builtin_amdgcn_perm(u0_, t0_, 0x05040100u), wd, acc[4 * d + 0], false);
                        acc[4 * d + 1] = __builtin_amdgcn_sdot4((int)__builtin_amdgcn_perm(u0_, t0_, 0x07060302u), wd, acc[4 * d + 1], false);
                        acc[4 * d + 2] = __builtin_amdgcn_sdot4((int)__builtin_amdgcn_perm(u1_, t1_, 0x05040100u), wd, acc[4 * d + 2], false);
                        acc[4 * d + 3] = __builtin_amdgcn_sdot4((int)__builtin_amdgcn_perm(u1_, t1_, 0x07060302u), wd, acc[4 * d + 3], false); } } }
            int q4[8], q2[4], q1[2];
#define SWAPSUMI(fn, lo_, hi_) ({ auto r_ = fn((unsigned)(lo_), (unsigned)(hi_), false, false); const unsigned r0_ = r_[0], r1_ = r_[1]; (int)(r0_ + r1_); })
#pragma unroll
            for (int c = 0; c < 8; ++c) q4[c] = SWAPSUMI(__builtin_amdgcn_permlane32_swap, acc[c], acc[c + 8]);
#pragma unroll
            for (int c = 0; c < 4; ++c) q2[c] = SWAPSUMI(__builtin_amdgcn_permlane16_swap, q4[c], q4[c + 4]);
#pragma unroll
            for (int c = 0; c < 2; ++c) { const bool hi = (lane & 8) != 0; const int send = hi ? q2[c] : q2[c + 2], keep = hi ? q2[c + 2] : q2[c]; q1[c] = keep + DPPI(send, 0x128); }
            const float wsc = WSC[tok];
            const f32x2_t val = {x1.x + (float)q1[0] * wsc, x1.y + (float)q1[1] * wsc};
            if (dostore) __builtin_nontemporal_store(val, (f32x2_t*)op); else asm volatile("" :: "v"(val.x), "v"(val.y), "v"(op)); };
        { UBuf A, B; uload(A, 0);
          if (xmode != 4) for (int it = 0; it < NIT; it += 2) { if ((it & (16 * MK_ALIGN_EVERY - 1)) == 0) xcd_align(bar); uload(B, it + 1); ucomp(A, it); if (it + 2 < NIT) uload(A, it + 2); ucomp(B, it + 1); } }
    }
}

constexpr int N_PHASES = 11;
struct Args { const float* in[24]; float* out; unsigned char* ws; int ph_lo, ph_hi, li, pad; };
__global__ void __launch_bounds__(NWAVES * 64, 2) mk_fwd(Args args) {
    extern __shared__ __attribute__((aligned(16))) unsigned char lds[];
    Frame F;
    F.lds = (LAS unsigned char*)lds;
    F.MISC = (volatile LAS unsigned*)(F.lds + MISC_OFF);
    F.tid = threadIdx.x; F.lane = F.tid & 63; F.wave = __builtin_amdgcn_readfirstlane(F.tid >> 6);
    F.G = gridDim.x; { const int bx = blockIdx.x; F.vcu = (F.G % 8 == 0) ? (bx % 8) * (F.G / 8) + bx / 8 : bx; }
    F.ws = args.ws; F.out = args.out; F.ctl = (gu32*)(args.ws + WS_CTL);
    F.in = args.in;
    for (int u = F.tid; u < (LDS_BYTES - LDSCTL_OFF) / 4; u += NWAVES * 64) ((LAS unsigned*)(F.lds + LDSCTL_OFF))[u] = 0u;
    __syncthreads();
    const int lo = args.ph_lo, hi = args.ph_hi;
    XcdBarrier bar; bar.bar = (unsigned*)(F.ctl + CW_BAR); bar.x = 0; bar.st = nullptr;
    if (hi - lo > 1) bar = xcd_barrier_post((unsigned*)(F.ctl + CW_BAR), F.MISC + 8);
#define IN(k) (lo <= (k) && (k) < hi)
#define BOTH(k) (IN(k) && IN((k) + 1))
#define GRID_BAR() xcd_barrier(bar)
#ifndef MK_PROBE_PHASE
#define MK_PROBE_PHASE -1
#endif
#ifndef MK_PROBE_REPS
#define MK_PROBE_REPS 1
#endif
#define REP(k) for (int rp_ = 0; rp_ < ((k) == MK_PROBE_PHASE ? 1 + MK_PROBE_REPS : 1); ++rp_)
    unsigned char* ws = args.ws;
    bf16* BUFA = (bf16*)(ws + WS_BUFA); bf16* BUFB = (bf16*)(ws + WS_BUFB);

    if (IN(0)) { REP(0) {
            if (F.vcu & 1) { p0_prologue(F); __syncthreads(); }
            for (int wi = F.vcu; wi < SSM_G * 4; wi += F.G) ssm::precompute_group(F, wi >> 2, wi & 3);
            if (!(F.vcu & 1)) { __syncthreads(); p0_prologue(F); } }
        if (MK_PROBE_PHASE == 20) for (int wi = F.vcu; wi < SSM_G * 4; wi += F.G) ssm::precompute_group(F, wi >> 2, wi & 3);
        if (MK_PROBE_PHASE == 21) p0_prologue(F, 1);
        if (MK_PROBE_PHASE == 22) p0_prologue(F, 2);
        if (BOTH(0)) GRID_BAR(); }
    if (IN(1)) {
        w8_convert_phase(F);
        GRID_BAR();
        pg8::Gemm g8{(const bf16*)(ws + WS_H8), (const bf16*)(ws + WS_W8), T_TOK, IN_W, D_MODEL / 2}; pg8::StaticOrder S8; S8.init(T_TOK, IN_W, F.G, (int)blockIdx.x);
        pg8::EpiProj8 E8{ws, WS_Q, WS_KV, WS_U, WS_GT, WS_HS, WS_CTL + (size_t)CW_AMAX * 4};
        REP(1) pg8::gemm_phase<pg8::EpiProj8, pg8::StaticOrder, true, true, true>(F.lds + RING_OFF, g8, S8, E8);
        if (BOTH(1)) GRID_BAR();
    }
    if (IN(2)) { REP(2) ssm_mfma_phase(F); }

    if (IN(4)) { REP(4) attn_flash_phase(F); if (BOTH(4)) GRID_BAR(); }
    if (IN(5)) {
        pg8::Gemm g{(const bf16*)(ws + WS_BUFA), (const bf16*)(ws + WS_WAO8), T_TOK, D_MODEL, D_MODEL / 2}; pg8::StaticOrder S; S.init(T_TOK, D_MODEL, F.G, (int)blockIdx.x);
        pg8::EpiGateMul8 E{ws, WS_BUFB, WS_GT, WS_CTL + (size_t)CW_AMAX_AO * 4, 1.0f / (440.0f * O8_SCALE)};
        REP(5) pg8::gemm_phase<pg8::EpiGateMul8, pg8::StaticOrder, true, true, true>(F.lds + RING_OFF, g, S, E);
        if (BOTH(5)) GRID_BAR();
    }
    if (IN(6)) {
        pg8::Gemm g{(const bf16*)(ws + WS_YACT), (const bf16*)(ws + WS_WGLU8), T_TOK, 4096, SSM_W / 2, 1}; pg8::StaticOrder S; S.init(T_TOK, 4096, F.G, (int)blockIdx.x);
        pg8::EpiGlu8 E{ws, WS_BUFA, WS_BUFB, WS_GT + 2048 * 2, WS_CTL + (size_t)CW_AMAX_GLU * 4, 1.0f / (440.0f * Y8_SCALE), M8_SCALE};
        REP(6) pg8::gemm_phase<pg8::EpiGlu8, pg8::StaticOrder, true, true, true>(F.lds + RING_OFF, g, S, E);
        if (BOTH(6)) GRID_BAR();
    }
    if (IN(7)) {
        REP(11) peer_tables_phase(F);
        pg8::Gemm g{BUFA, (const bf16*)(ws + WS_WOUT8), T_TOK, D_MODEL, D_MODEL / 2}; pg8::StaticOrder S; S.init(T_TOK, D_MODEL, F.G, (int)blockIdx.x);
        pg8::EpiResid8 E{ws, F.in[IN_X], WS_BUFB, WS_SSQ, WS_CTL + (size_t)CW_AMAX_OUT * 4, 1.0f / (440.0f * M8_SCALE)};
        REP(7) pg8::gemm_phase<pg8::EpiResid8, pg8::StaticOrder, true, true, true>(F.lds + RING_OFF, g, S, E);
        if (BOTH(7)) GRID_BAR();
    }
    if (IN(8)) {
        pg8::Gemm g{BUFB, (const bf16*)(ws + WS_WPQ), T_TOK, D_MODEL, D_MODEL}; pg8::StaticOrder S; S.init(T_TOK, D_MODEL, F.G, (int)blockIdx.x);
        pg8::EpiPlain E{BUFA, D_MODEL};
        REP(8) pg8::gemm_phase<pg8::EpiPlain, pg8::StaticOrder, true, true>(F.lds + RING_OFF, g, S, E);
        if (BOTH(8)) GRID_BAR();
    }
    if (IN(9)) { REP(9) peer_score_mfma_phase(F); if (BOTH(9)) GRID_BAR(); }
    if (IN(10)) { for (int rp_ = 0; rp_ < (10 == MK_PROBE_PHASE ? MK_PROBE_REPS : 0); ++rp_) peer_expert_sliced_phase(F, bar, false); peer_expert_sliced_phase(F, bar, true); }
#undef IN
#undef BOTH
}

#ifndef MK_ONE_LAUNCH
#define MK_ONE_LAUNCH 1
#endif
extern "C" void kernel_launch(void* const* d_in, const int* in_sizes, int n_in, void* d_out, int out_size, void* d_ws, size_t ws_size, hipStream_t stream) {
    static int grid = 0;
    if (grid == 0) {
        if (n_in != 24 || in_sizes[0] != T_TOK * D_MODEL || out_size != T_TOK * D_MODEL || ws_size < WS_END) {
            fprintf(stderr, "kernel_launch: shape mismatch: n_in %d in0 %d out %d ws %zu (need >= %zu)\n", n_in, n_in > 0 ? in_sizes[0] : -1, out_size, ws_size, (size_t)WS_END); grid = -1; return; }
        int dev = 0, cus = 0, per_cu = 0;
        if (hipGetDevice(&dev) != hipSuccess || hipDeviceGetAttribute(&cus, hipDeviceAttributeMultiprocessorCount, dev) != hipSuccess) { fprintf(stderr, "kernel_launch: device query failed\n"); grid = -1; return; }
        if (hipFuncSetAttribute((const void*)mk_fwd, hipFuncAttributeMaxDynamicSharedMemorySize, LDS_BYTES) != hipSuccess) { fprintf(stderr, "kernel_launch: hipFuncSetAttribute failed\n"); grid = -1; return; }
        if (hipOccupancyMaxActiveBlocksPerMultiprocessor(&per_cu, (const void*)mk_fwd, NWAVES * 64, LDS_BYTES) != hipSuccess || per_cu < 1)
            fprintf(stderr, "kernel_launch: note: occupancy query reports %d workgroups per CU\n", per_cu);
        (void)hipGetLastError();
        grid = cus;
    }
    if (grid < 0) return;
    if (hipMemsetAsync((char*)d_ws + WS_CTL, 0, CTL_ZERO_BYTES, stream) != hipSuccess) { fprintf(stderr, "kernel_launch: memset failed\n"); return; }
    Args a{};
    for (int i = 0; i < 24; ++i) a.in[i] = (const float*)d_in[i];
    a.out = (float*)d_out; a.ws = (unsigned char*)d_ws;
#if MK_ONE_LAUNCH
    a.ph_lo = 0; a.ph_hi = N_PHASES; a.li = 0;
    void* kargs[] = {&a};
    hipError_t le = hipLaunchCooperativeKernel((const void*)mk_fwd, dim3(grid), dim3(NWAVES * 64), kargs, LDS_BYTES, stream);
    if (le != hipSuccess) fprintf(stderr, "kernel_launch: cooperative launch failed: %s\n", hipGetErrorName(le));
#else
    for (int li = 0; li < N_PHASES; ++li) {
        a.ph_lo = li; a.ph_hi = li + 1; a.li = li;
        hipLaunchKernelGGL(mk_fwd, dim3(grid), dim3(NWAVES * 64), LDS_BYTES, stream, a);
        const hipError_t le = hipPeekAtLastError();
        if (le != hipSuccess) { fprintf(stderr, "kernel_launch: launch %d failed: %s\n", li, hipGetErrorName(le)); break; }
    }
#endif
}
```
